# Optimizing an MI355X kernel written in HIP

```python
import jax, jax.numpy as jnp
from jax import lax
import numpy as np

D_MODEL = 1024
BATCH = 8
SEQ = 2048
DEPTH = 1

CTX_LEN = 256
GRID_W = 64
CHUNK = 64
N_DIR = 2
GLA_HEADS = 4
GLA_DK = 64
GLA_DV = 128
GLA_RANK = 16
GLA_TAU = 16.0
GLA_QK = GLA_HEADS * GLA_DK
GLA_V = GLA_HEADS * GLA_DV
GDN_HEADS = 4
GDN_DK = 128
GDN_DV = 128
GDN_QK = GDN_HEADS * GDN_DK
GDN_V = GDN_HEADS * GDN_DV
CONV_K = 3
CONV_CH = 2 * GDN_QK + GDN_V
EPS = 1e-6
SPLIT_SIZES = (GLA_QK, GLA_QK, GLA_V, GLA_V, N_DIR * GLA_RANK,
               GDN_QK, GDN_QK, GDN_V, GDN_V, N_DIR * GDN_HEADS, N_DIR * GDN_HEADS,
               2 * D_MODEL)
D_IN = sum(SPLIT_SIZES)

kernel_name = 'hybrid_gla_gdn_prefix_dit_block'


def rmsnorm(x, g):
    xf = x.astype(jnp.float32)
    y = xf * lax.rsqrt(jnp.mean(xf * xf, axis=-1, keepdims=True) + EPS)
    return (y * g.astype(jnp.float32)).astype(x.dtype)


def l2norm(x):
    return x * lax.rsqrt(jnp.sum(x * x, axis=-1, keepdims=True) + EPS)


def rev(a):
    return jnp.flip(a, axis=1)


def split_cols(z):
    outs = []
    start = 0
    for size in SPLIT_SIZES:
        outs.append(z[..., start:start + size])
        start += size
    return outs


def conv_grid(u, w):
    b, t, ch = u.shape
    rows = t // GRID_W
    ug = u.reshape(b, rows, GRID_W, ch)
    out = lax.conv_general_dilated(ug, w[:, :, None, :].astype(u.dtype), window_strides=(1, 1), padding='SAME',
                                   dimension_numbers=('NHWC', 'HWIO', 'NHWC'), feature_group_count=ch)
    return out.reshape(b, t, ch)


def conv_seq(u, w):
    ch = u.shape[-1]
    return lax.conv_general_dilated(u, w[1][:, None, :].astype(u.dtype), window_strides=(1,), padding='SAME',
                                    dimension_numbers=('NWC', 'WIO', 'NWC'), feature_group_count=ch)


def to_chunks(a):
    b, t, h, d = a.shape
    return a.reshape(b, t // CHUNK, CHUNK, h, d).transpose(1, 0, 3, 2, 4)


def from_chunks(a):
    n, b, h, c, d = a.shape
    return a.transpose(1, 0, 3, 2, 4).reshape(b, n * c, h, d)


def gla_chunked(q, k, v, g, s0):
    qc, kc, vc, gc = to_chunks(q), to_chunks(k), to_chunks(v), to_chunks(g)
    bc = jnp.cumsum(gc, axis=3)
    causal = jnp.tril(jnp.ones((CHUNK, CHUNK), dtype=bool))

    def step(s, inp):
        qi, ki, vi, bi = inp
        diff = bi[:, :, :, None, :] - bi[:, :, None, :, :]
        dec = jnp.exp(jnp.where(causal[:, :, None], diff, -jnp.inf))
        att = jnp.einsum('bhtd,bhsd,bhtsd->bhts', qi, ki, dec)
        o = jnp.einsum('bhtd,bhde->bhte', qi * jnp.exp(bi), s) + jnp.einsum('bhts,bhse->bhte', att, vi)
        bl = bi[:, :, -1:, :]
        s_new = s * jnp.exp(bl[:, :, 0, :])[..., None] + jnp.einsum('bhsd,bhse->bhde', ki * jnp.exp(bl - bi), vi)
        return s_new, o

    s_fin, o = lax.scan(step, s0, (qc, kc, vc, bc))
    return from_chunks(o), s_fin


def gdn_chunked(q, k, v, g, beta, s0):
    qc, kc, vc = to_chunks(q), to_chunks(k), to_chunks(v)
    gc = to_chunks(g[..., None])[..., 0]
    bc = to_chunks(beta[..., None])
    gam = jnp.cumsum(gc, axis=-1)
    incl = jnp.tril(jnp.ones((CHUNK, CHUNK), dtype=bool))
    strict = jnp.tril(jnp.ones((CHUNK, CHUNK), dtype=bool), -1)
    dmask = jnp.exp(jnp.where(incl, gam[..., :, None] - gam[..., None, :], -jnp.inf))
    kb = kc * bc
    vb = vc * bc
    low = jnp.where(strict, jnp.einsum('nbhid,nbhjd->nbhij', kb, kc) * dmask, 0.0)
    eye = jnp.eye(CHUNK, dtype=low.dtype)
    tmat = lax.linalg.triangular_solve(eye + low, jnp.broadcast_to(eye, low.shape), left_side=True, lower=True)
    u = jnp.matmul(tmat, vb)
    w = jnp.matmul(tmat, kb * jnp.exp(gam)[..., None])
    aqk = jnp.einsum('nbhid,nbhjd->nbhij', qc, kc) * dmask

    def step(s, inp):
        qi, ki, ui, wi, ai, gi = inp
        v_new = ui - jnp.matmul(wi, s)
        o = jnp.matmul(qi * jnp.exp(gi)[..., None], s) + jnp.matmul(ai, v_new)
        gl = gi[..., -1]
        s_new = s * jnp.exp(gl)[..., None, None] + jnp.einsum('bhcd,bhce->bhde', ki * jnp.exp(gl[..., None] - gi)[..., None], v_new)
        return s_new, o

    s_fin, o = lax.scan(step, s0, (qc, kc, u, w, aqk, gam))
    return from_chunks(o), s_fin


def branch_inputs(h, w_in, gla_up, gla_ub, gdn_conv, gdn_a_log, gdn_dt_bias, on_grid):
    f32 = jnp.float32
    b, t, _ = h.shape
    z = jnp.matmul(h, w_in).astype(f32)
    aq, ak, av, ag, alr, bq, bk, bv, bg, bbeta, bdec, mg = split_cols(z)
    aq = aq.reshape(b, t, GLA_HEADS, GLA_DK) * (GLA_DK ** -0.5)
    ak = ak.reshape(b, t, GLA_HEADS, GLA_DK)
    av = av.reshape(b, t, GLA_HEADS, GLA_DV)
    alr = alr.reshape(b, t, N_DIR, GLA_RANK)
    alog = jax.nn.log_sigmoid(jnp.einsum('btnr,nrk->btnk', alr, gla_up.astype(f32)) + gla_ub.astype(f32)) / GLA_TAU
    alog = alog.reshape(b, t, N_DIR, GLA_HEADS, GLA_DK)
    qkv = jnp.concatenate([bq, bk, bv], axis=-1)
    qkv = jax.nn.silu(conv_grid(qkv, gdn_conv) if on_grid else conv_seq(qkv, gdn_conv))
    bq = l2norm(qkv[..., :GDN_QK].reshape(b, t, GDN_HEADS, GDN_DK)) * (GDN_DK ** -0.5)
    bk = l2norm(qkv[..., GDN_QK:2 * GDN_QK].reshape(b, t, GDN_HEADS, GDN_DK))
    bv = qkv[..., 2 * GDN_QK:].reshape(b, t, GDN_HEADS, GDN_DV)
    beta = jax.nn.sigmoid(bbeta.reshape(b, t, N_DIR, GDN_HEADS))
    glog = -jnp.exp(gdn_a_log.astype(f32)) * jax.nn.softplus(bdec.reshape(b, t, N_DIR, GDN_HEADS) + gdn_dt_bias.astype(f32))
    return aq, ak, av, ag, alog, bq, bk, bv, bg, beta, glog, mg


def run_mixers(aq, ak, av, alog, bq, bk, bv, beta, glog, sa_f, sa_b, sb_f, sb_b):
    oa_f, sa_f = gla_chunked(aq, ak, av, alog[:, :, 0], sa_f)
    oa_b, sa_b = gla_chunked(rev(aq), rev(ak), rev(av), rev(alog[:, :, 1]), sa_b)
    ob_f, sb_f = gdn_chunked(bq, bk, bv, glog[:, :, 0], beta[:, :, 0], sb_f)
    ob_b, sb_b = gdn_chunked(rev(bq), rev(bk), rev(bv), rev(glog[:, :, 1]), rev(beta[:, :, 1]), sb_b)
    return oa_f + rev(oa_b), ob_f + rev(ob_b), sa_f, sa_b, sb_f, sb_b


def branch_merge(oa, ob, ag, bg, mg, gla_onorm, gdn_onorm, w_gla_out, w_gdn_out, b_gate, w_o):
    b, t = oa.shape[0], oa.shape[1]
    ya = rmsnorm(oa, gla_onorm).reshape(b, t, GLA_V) * jax.nn.silu(ag)
    yb = rmsnorm(ob, gdn_onorm).reshape(b, t, GDN_V) * jax.nn.silu(bg)
    gates = jax.nn.sigmoid(mg + b_gate.astype(jnp.float32))
    merged = gates[..., :D_MODEL] * jnp.matmul(ya, w_gla_out) + gates[..., D_MODEL:] * jnp.matmul(yb, w_gdn_out)
    return jnp.matmul(merged, w_o)


def setup_inputs(seed: int = 0) -> dict:
    key = jax.random.key(seed)
    ks = jax.random.split(key, 24)

    def nrm(k, shape, scale):
        return jax.random.normal(k, shape, jnp.float32) * scale

    dt = jnp.exp(jax.random.uniform(ks[13], (DEPTH, N_DIR, GDN_HEADS), jnp.float32, np.log(1e-3), np.log(1e-1)))
    return {
        'x': nrm(ks[0], (BATCH, SEQ, D_MODEL), 1.0),
        'c': nrm(ks[1], (BATCH, D_MODEL), 1.0),
        'ctx': nrm(ks[2], (BATCH, CTX_LEN, D_MODEL), 1.0),
        'c_ctx': nrm(ks[3], (D_MODEL,), 1.0),
        'w_mod': nrm(ks[4], (DEPTH, D_MODEL, 3 * D_MODEL), 0.5 * D_MODEL ** -0.5),
        'b_mod': nrm(ks[5], (DEPTH, 3 * D_MODEL), 0.02),
        'norm_g': 1.0 + nrm(ks[6], (DEPTH, D_MODEL), 0.05),
        'w_in': nrm(ks[7], (DEPTH, D_MODEL, D_IN), D_MODEL ** -0.5),
        'gla_up': nrm(ks[8], (DEPTH, N_DIR, GLA_RANK, GLA_QK), GLA_RANK ** -0.5),
        'gla_ub': nrm(ks[9], (DEPTH, N_DIR, GLA_QK), 0.1),
        'gla_onorm': 1.0 + nrm(ks[10], (DEPTH, GLA_DV), 0.05),
        'gdn_conv': nrm(ks[11], (DEPTH, CONV_K, CONV_K, CONV_CH), 1.0 / CONV_K),
        'gdn_a_log': jnp.log(jax.random.uniform(ks[12], (DEPTH, N_DIR, GDN_HEADS), jnp.float32, 1.0, 16.0)),
        'gdn_dt_bias': dt + jnp.log(-jnp.expm1(-dt)),
        'gdn_onorm': 1.0 + nrm(ks[14], (DEPTH, GDN_DV), 0.05),
        'w_gla_out': nrm(ks[15], (DEPTH, GLA_V, D_MODEL), GLA_V ** -0.5),
        'w_gdn_out': nrm(ks[16], (DEPTH, GDN_V, D_MODEL), GDN_V ** -0.5),
        'b_gate': nrm(ks[17], (DEPTH, 2 * D_MODEL), 0.1),
        'w_o': nrm(ks[18], (DEPTH, D_MODEL, D_MODEL), D_MODEL ** -0.5),
        'final_g': 1.0 + nrm(ks[19], (D_MODEL,), 0.05),
    }


def reference(x, c, ctx, c_ctx, w_mod, b_mod, norm_g, w_in, gla_up, gla_ub, gla_onorm, gdn_conv,
              gdn_a_log, gdn_dt_bias, gdn_onorm, w_gla_out, w_gdn_out, b_gate, w_o, final_g):
    dtype = x.dtype
    b = x.shape[0]
    f32 = jnp.float32
    for l in range(DEPTH):
        mod_x = jnp.matmul(jax.nn.silu(c), w_mod[l]) + b_mod[l]
        mod_c = jnp.matmul(jax.nn.silu(c_ctx), w_mod[l]) + b_mod[l]
        sh_x, sc_x, gt_x = mod_x[:, :D_MODEL], mod_x[:, D_MODEL:2 * D_MODEL], mod_x[:, 2 * D_MODEL:]
        sh_c, sc_c, gt_c = mod_c[:D_MODEL], mod_c[D_MODEL:2 * D_MODEL], mod_c[2 * D_MODEL:]
        hx = rmsnorm(x, norm_g[l]) * (1.0 + sc_x[:, None, :]) + sh_x[:, None, :]
        hc = rmsnorm(ctx, norm_g[l]) * (1.0 + sc_c) + sh_c

        (caq, cak, cav, cag, calog, cbq, cbk, cbv, cbg, cbeta, cglog, cmg) = branch_inputs(
            hc, w_in[l], gla_up[l], gla_ub[l], gdn_conv[l], gdn_a_log[l], gdn_dt_bias[l], False)
        za = jnp.zeros((b, GLA_HEADS, GLA_DK, GLA_DV), f32)
        zb = jnp.zeros((b, GDN_HEADS, GDN_DK, GDN_DV), f32)
        coa, cob, sa_f, sa_b, sb_f, sb_b = run_mixers(caq, cak, cav, calog, cbq, cbk, cbv, cbeta, cglog, za, za, zb, zb)

        (aq, ak, av, ag, alog, bq, bk, bv, bg, beta, glog, mg) = branch_inputs(
            hx, w_in[l], gla_up[l], gla_ub[l], gdn_conv[l], gdn_a_log[l], gdn_dt_bias[l], True)
        oa, ob, _, _, _, _ = run_mixers(aq, ak, av, alog, bq, bk, bv, beta, glog, sa_f, sa_b, sb_f, sb_b)
        out_x = branch_merge(oa, ob, ag, bg, mg, gla_onorm[l], gdn_onorm[l], w_gla_out[l], w_gdn_out[l], b_gate[l], w_o[l])
        if l < DEPTH - 1:
            out_c = branch_merge(coa, cob, cag, cbg, cmg, gla_onorm[l], gdn_onorm[l], w_gla_out[l], w_gdn_out[l], b_gate[l], w_o[l])
            ctx = ctx + (gt_c * out_c).astype(dtype)
        x = x + (gt_x[:, None, :] * out_x).astype(dtype)
    return rmsnorm(x, final_g)
```

```cpp
#ifndef HOST_EMU
#include <hip/hip_runtime.h>
#define KERNEL __global__
#define KERNEL128 __global__ __launch_bounds__(128)
#define UNROLL _Pragma("unroll")
#define DEV __device__ __forceinline__
#else
#include <cmath>
#include <cstdio>
#include <cstdlib>
#include <cstring>
#include <vector>
struct dim3_ { int x; };
static thread_local dim3_ blockIdx, threadIdx, blockDim, gridDim;
#define KERNEL static
#define KERNEL128 static
#define UNROLL
#define DEV static inline
typedef void* hipStream_t;
static inline float atomicAdd(float* p, float v) { float o;
#pragma omp atomic capture
    { o = *p; *p += v; }
    return o; }
#endif

#ifndef D_MODEL
#define D_MODEL 1024
#define BATCH 8
#define SEQ 2048
#define CTX_LEN 256
#define GLA_HEADS 4
#define GLA_DK 64
#define GLA_DV 128
#define GLA_RANK 16
#define GDN_HEADS 4
#define GDN_DK 128
#define GDN_DV 128
#endif
#define GRID_W 64
#define N_DIR 2
#define GLA_QK (GLA_HEADS * GLA_DK)
#define GLA_V (GLA_HEADS * GLA_DV)
#define GDN_QK (GDN_HEADS * GDN_DK)
#define GDN_V (GDN_HEADS * GDN_DV)
#define CONV_CH (2 * GDN_QK + GDN_V)
#define EPSV 1e-6f
#define C_AQ 0
#define C_AK (C_AQ + GLA_QK)
#define C_AV (C_AK + GLA_QK)
#define C_AG (C_AV + GLA_V)
#define C_ALR (C_AG + GLA_V)
#define C_BQ (C_ALR + N_DIR * GLA_RANK)
#define C_BK (C_BQ + GDN_QK)
#define C_BV (C_BK + GDN_QK)
#define C_BG (C_BV + GDN_V)
#define C_BBETA (C_BG + GDN_V)
#define C_BDEC (C_BBETA + N_DIR * GDN_HEADS)
#define C_MG (C_BDEC + N_DIR * GDN_HEADS)
#define D_IN (C_MG + 2 * D_MODEL)
#define NZA C_MG
#define NTOK (BATCH * SEQ)
#define NCTX (BATCH * CTX_LEN)
#define NROWS (NTOK + NCTX)

typedef unsigned short bf16;
DEV bf16 f2bf(float f) { unsigned u; memcpy(&u, &f, 4); u = (u + 0x7fffu + ((u >> 16) & 1u)) >> 16; return (bf16)u; }
DEV float bf2f(bf16 b) { unsigned u = ((unsigned)b) << 16; float f; memcpy(&f, &u, 4); return f; }
DEV float siluf(float x) { return x / (1.f + expf(-x)); }
DEV float sigmf(float x) { return 1.f / (1.f + expf(-x)); }
DEV float softplusf(float x) { return fmaxf(x, 0.f) + log1pf(expf(-fabsf(x))); }
DEV float logsigf(float x) { return fminf(x, 0.f) - log1pf(expf(-fabsf(x))); }

struct P {
    const float *x, *c, *ctx, *c_ctx, *w_mod, *b_mod, *norm_g, *w_in, *gla_up, *gla_ub, *gla_onorm, *gdn_conv, *gdn_a_log, *gdn_dt_bias, *gdn_onorm,
        *w_gla_out, *w_gdn_out, *b_gate, *w_o, *final_g;
    float* out;
    bf16 *Z, *H, *QKV, *YA, *YB, *MERGED; float *MOD, *OA, *OB;
};

#define GTID (blockIdx.x * blockDim.x + threadIdx.x)

KERNEL void k_mod(P p) {
    int i = GTID; if (i >= (BATCH + 1) * 3 * D_MODEL) return;
    int r = i / (3 * D_MODEL), j = i % (3 * D_MODEL);
    const float* cv = r < BATCH ? p.c + r * D_MODEL : p.c_ctx;
    float s = 0.f;
    for (int k = 0; k < D_MODEL; ++k) s += siluf(cv[k]) * p.w_mod[(size_t)k * 3 * D_MODEL + j];
    p.MOD[i] = s + p.b_mod[j];
}
KERNEL void k_h(P p) {
    int row = GTID; if (row >= NROWS) return;
    const float* xr; int r;
    if (row < NTOK) { xr = p.x + (size_t)row * D_MODEL; r = row / SEQ; } else { xr = p.ctx + (size_t)(row - NTOK) * D_MODEL; r = BATCH; }
    float ss = 0.f; for (int k = 0; k < D_MODEL; ++k) ss += xr[k] * xr[k];
    float rstd = 1.f / sqrtf(ss / D_MODEL + EPSV);
    const float* sh = p.MOD + (size_t)r * 3 * D_MODEL; const float* sc = sh + D_MODEL;
    for (int k = 0; k < D_MODEL; ++k) p.H[(size_t)row * D_MODEL + k] = f2bf((xr[k] * rstd * p.norm_g[k]) * (1.f + sc[k]) + sh[k]);
}
KERNEL void k_inproj(P p) {
    size_t i = (size_t)blockIdx.x * blockDim.x + threadIdx.x; if (i >= (size_t)NROWS * NZA) return;
    int row = (int)(i / NZA), n = (int)(i % NZA);
    const bf16* h = p.H + (size_t)row * D_MODEL; float s = 0.f;
    for (int k = 0; k < D_MODEL; ++k) s += bf2f(h[k]) * p.w_in[(size_t)k * D_IN + n];
    p.Z[i] = f2bf(s);
}
DEV float conv_at(const P& p, int row, int ch) {
    float acc = 0.f;
    if (row < NTOK) {
        int b = row / SEQ, t = row % SEQ, gy = t / GRID_W, gx = t % GRID_W;
        for (int dy = 0; dy < 3; ++dy) { int yy = gy + dy - 1; if (yy < 0 || yy >= SEQ / GRID_W) continue;
            for (int dx = 0; dx < 3; ++dx) { int xx = gx + dx - 1; if (xx < 0 || xx >= GRID_W) continue;
                acc += bf2f(p.Z[(size_t)(b * SEQ + yy * GRID_W + xx) * NZA + C_BQ + ch]) * p.gdn_conv[(dy * 3 + dx) * CONV_CH + ch]; } }
    } else {
        int rr = row - NTOK, b = rr / CTX_LEN, t = rr % CTX_LEN;
        for (int dx = 0; dx < 3; ++dx) { int tt = t + dx - 1; if (tt < 0 || tt >= CTX_LEN) continue;
            acc += bf2f(p.Z[(size_t)(NTOK + b * CTX_LEN + tt) * NZA + C_BQ + ch]) * p.gdn_conv[(1 * 3 + dx) * CONV_CH + ch]; }
    }
    return siluf(acc);
}
KERNEL void k_conv(P p) {
    int i = GTID; if (i >= NROWS * 3 * GDN_HEADS) return;
    int row = i / (3 * GDN_HEADS), wh = (i / GDN_HEADS) % 3, h = i % GDN_HEADS;
    const int dh = (wh == 2) ? GDN_DV : GDN_DK; const int ch0 = (wh == 0 ? 0 : wh == 1 ? GDN_QK : 2 * GDN_QK) + h * dh;
    float scale = 1.f;
    if (wh < 2) { float ss = 0.f; for (int d = 0; d < dh; ++d) { float v = conv_at(p, row, ch0 + d); ss += v * v; }
        scale = 1.f / sqrtf(ss + EPSV); if (wh == 0) scale *= 1.f / sqrtf((float)GDN_DK); }
    for (int d = 0; d < dh; ++d) p.QKV[(size_t)row * CONV_CH + ch0 + d] = f2bf(conv_at(p, row, ch0 + d) * scale);
}
DEV int scan_row(int b, int dir, int pos, bool& latent, int& tok) {
    if (pos < CTX_LEN) { latent = false; tok = dir ? CTX_LEN - 1 - pos : pos; return NTOK + b * CTX_LEN + tok; }
    int q = pos - CTX_LEN; latent = true; tok = dir ? SEQ - 1 - q : q; return b * SEQ + tok;
}
KERNEL128 void k_scan_gdn(P p) {
    int e = threadIdx.x; int bid = blockIdx.x; int dir = bid % 2, h = (bid / 2) % GDN_HEADS, b = bid / (2 * GDN_HEADS);
    if (e >= GDN_DV) return;
    float S[GDN_DK]; UNROLL for (int d = 0; d < GDN_DK; ++d) S[d] = 0.f;
    const float A = -expf(p.gdn_a_log[dir * GDN_HEADS + h]), dtb = p.gdn_dt_bias[dir * GDN_HEADS + h];
    for (int pos = 0; pos < CTX_LEN + SEQ; ++pos) {
        bool lat; int tok; int row = scan_row(b, dir, pos, lat, tok);
        const bf16* q = p.QKV + (size_t)row * CONV_CH + h * GDN_DK; const bf16* k = q + GDN_QK; float v = bf2f(p.QKV[(size_t)row * CONV_CH + 2 * GDN_QK + h * GDN_DV + e]);
        const bf16* z = p.Z + (size_t)row * NZA;
        float beta = sigmf(bf2f(z[C_BBETA + dir * GDN_HEADS + h]));
        float g = A * softplusf(bf2f(z[C_BDEC + dir * GDN_HEADS + h]) + dtb), eg = expf(g);
        float ks = 0.f; UNROLL for (int d = 0; d < GDN_DK; ++d) ks += bf2f(k[d]) * S[d];
        float vn = beta * (v - eg * ks);
        float o = 0.f; UNROLL for (int d = 0; d < GDN_DK; ++d) { S[d] = eg * S[d] + bf2f(k[d]) * vn; o += bf2f(q[d]) * S[d]; }
        if (lat) atomicAdd(&p.OB[(size_t)row * GDN_V + h * GDN_DV + e], o);
    }
}
KERNEL128 void k_scan_gla(P p) {
    int e = threadIdx.x; int bid = blockIdx.x; int dir = bid % 2, h = (bid / 2) % GLA_HEADS, b = bid / (2 * GLA_HEADS);
    if (e >= GLA_DV) return;
    float S[GLA_DK]; UNROLL for (int d = 0; d < GLA_DK; ++d) S[d] = 0.f;
    for (int pos = 0; pos < CTX_LEN + SEQ; ++pos) {
        bool lat; int tok; int row = scan_row(b, dir, pos, lat, tok);
        const bf16* z = p.Z + (size_t)row * NZA;
        float v = bf2f(z[C_AV + h * GLA_DV + e]);
        float lr[GLA_RANK]; UNROLL for (int r = 0; r < GLA_RANK; ++r) lr[r] = bf2f(z[C_ALR + dir * GLA_RANK + r]);
        float o = 0.f;
        UNROLL for (int d = 0; d < GLA_DK; ++d) {
            float u = p.gla_ub[dir * GLA_QK + h * GLA_DK + d];
            UNROLL for (int r = 0; r < GLA_RANK; ++r) u += lr[r] * p.gla_up[(size_t)(dir * GLA_RANK + r) * GLA_QK + h * GLA_DK + d];
            float dec = expf(logsigf(u) * (1.f / 16.f));
            S[d] = dec * S[d] + bf2f(z[C_AK + h * GLA_DK + d]) * v;
            o += bf2f(z[C_AQ + h * GLA_DK + d]) * S[d];
        }
        if (lat) atomicAdd(&p.OA[(size_t)row * GLA_V + h * GLA_DV + e], o * (1.f / sqrtf((float)GLA_DK)));
    }
}
KERNEL void k_y(P p) {
    int i = GTID; if (i >= NTOK * (GLA_HEADS + GDN_HEADS)) return;
    int row = i / (GLA_HEADS + GDN_HEADS), hh = i % (GLA_HEADS + GDN_HEADS);
    if (hh < GLA_HEADS) { const float* o = p.OA + (size_t)row * GLA_V + hh * GLA_DV; float ss = 0.f; for (int e = 0; e < GLA_DV; ++e) ss += o[e] * o[e];
        float rs = 1.f / sqrtf(ss / GLA_DV + EPSV);
        for (int e = 0; e < GLA_DV; ++e) p.YA[(size_t)row * GLA_V + hh * GLA_DV + e] = f2bf(o[e] * rs * p.gla_onorm[e] * siluf(bf2f(p.Z[(size_t)row * NZA + C_AG + hh * GLA_DV + e])));
    } else { int h = hh - GLA_HEADS; const float* o = p.OB + (size_t)row * GDN_V + h * GDN_DV; float ss = 0.f; for (int e = 0; e < GDN_DV; ++e) ss += o[e] * o[e];
        float rs = 1.f / sqrtf(ss / GDN_DV + EPSV);
        for (int e = 0; e < GDN_DV; ++e) p.YB[(size_t)row * GDN_V + h * GDN_DV + e] = f2bf(o[e] * rs * p.gdn_onorm[e] * siluf(bf2f(p.Z[(size_t)row * NZA + C_BG + h * GDN_DV + e])));
    }
}
KERNEL void k_merged(P p) {
    size_t i = (size_t)blockIdx.x * blockDim.x + threadIdx.x; if (i >= (size_t)NTOK * D_MODEL) return;
    int row = (int)(i / D_MODEL), n = (int)(i % D_MODEL);
    const bf16* h = p.H + (size_t)row * D_MODEL; float ma = 0.f, mb = 0.f;
    for (int k = 0; k < D_MODEL; ++k) { float hv = bf2f(h[k]); ma += hv * p.w_in[(size_t)k * D_IN + C_MG + n]; mb += hv * p.w_in[(size_t)k * D_IN + C_MG + D_MODEL + n]; }
    float ga = sigmf(ma + p.b_gate[n]), gb = sigmf(mb + p.b_gate[D_MODEL + n]);
    float sa = 0.f, sb = 0.f;
    for (int k = 0; k < GLA_V; ++k) sa += bf2f(p.YA[(size_t)row * GLA_V + k]) * p.w_gla_out[(size_t)k * D_MODEL + n];
    for (int k = 0; k < GDN_V; ++k) sb += bf2f(p.YB[(size_t)row * GDN_V + k]) * p.w_gdn_out[(size_t)k * D_MODEL + n];
    p.MERGED[i] = f2bf(ga * sa + gb * sb);
}
KERNEL void k_out(P p) {
    size_t i = (size_t)blockIdx.x * blockDim.x + threadIdx.x; if (i >= (size_t)NTOK * D_MODEL) return;
    int row = (int)(i / D_MODEL), n = (int)(i % D_MODEL), b = row / SEQ;
    float s = 0.f; for (int k = 0; k < D_MODEL; ++k) s += bf2f(p.MERGED[(size_t)row * D_MODEL + k]) * p.w_o[(size_t)k * D_MODEL + n];
    p.out[i] = p.x[i] + p.MOD[(size_t)b * 3 * D_MODEL + 2 * D_MODEL + n] * s;
}
KERNEL void k_final(P p) {
    int row = GTID; if (row >= NTOK) return;
    float* y = p.out + (size_t)row * D_MODEL; float ss = 0.f; for (int k = 0; k < D_MODEL; ++k) ss += y[k] * y[k];
    float rs = 1.f / sqrtf(ss / D_MODEL + EPSV);
    for (int k = 0; k < D_MODEL; ++k) y[k] = y[k] * rs * p.final_g[k];
}

#ifndef HOST_EMU
#define LAUNCH(k, n, bs) hipLaunchKernelGGL(k, dim3((unsigned)(((size_t)(n) + (bs) - 1) / (bs))), dim3(bs), 0, stream, p)
#define LAUNCHB(k, nb, bs) hipLaunchKernelGGL(k, dim3(nb), dim3(bs), 0, stream, p)
#define MEMSET0(ptr, bytes) hipMemsetAsync(ptr, 0, bytes, stream)
#else
template <class K> static void run_grid(K k, size_t nb, int bs, P p) {
#pragma omp parallel for schedule(dynamic)
    for (long b = 0; b < (long)nb; ++b) for (int t = 0; t < bs; ++t) { blockIdx.x = (int)b; threadIdx.x = t; blockDim.x = bs; gridDim.x = (int)nb; k(p); }
}
#define LAUNCH(k, n, bs) run_grid(k, ((size_t)(n) + (bs) - 1) / (bs), bs, p)
#define LAUNCHB(k, nb, bs) run_grid(k, nb, bs, p)
#define MEMSET0(ptr, bytes) memset(ptr, 0, bytes)
#endif

extern "C" void kernel_launch(void* const* d_in, const int* in_sizes, int n_in, void* d_out, int out_size, void* d_ws, size_t ws_size, hipStream_t stream) {
    P p{}; const float** f = (const float**)&p;
    for (int i = 0; i < 20; ++i) f[i] = (const float*)d_in[i];
    p.out = (float*)d_out;
    char* ws = (char*)d_ws; size_t off = 0;
    auto carve = [&](size_t bytes) { char* r = ws + off; off += (bytes + 255) & ~(size_t)255; return r; };
    p.Z = (bf16*)carve((size_t)NROWS * NZA * 2);
    p.H = (bf16*)carve((size_t)NROWS * D_MODEL * 2);
    p.QKV = (bf16*)carve((size_t)NROWS * CONV_CH * 2);
    p.MOD = (float*)carve((size_t)(BATCH + 1) * 3 * D_MODEL * 4);
    p.YA = (bf16*)carve((size_t)NTOK * GLA_V * 2);
    p.YB = (bf16*)carve((size_t)NTOK * GDN_V * 2);
    p.MERGED = p.Z;
    p.OA = (float*)d_out; p.OB = p.OA + (size_t)NTOK * GLA_V;
    LAUNCH(k_mod, (BATCH + 1) * 3 * D_MODEL, 256);
    LAUNCH(k_h, NROWS, 64);
    LAUNCH(k_inproj, (size_t)NROWS * NZA, 256);
    LAUNCH(k_conv, NROWS * 3 * GDN_HEADS, 64);
    MEMSET0(d_out, (size_t)NTOK * D_MODEL * 4);
    LAUNCHB(k_scan_gdn, BATCH * GDN_HEADS * 2, 128);
    LAUNCHB(k_scan_gla, BATCH * GLA_HEADS * 2, 128);
    LAUNCH(k_y, NTOK * (GLA_HEADS + GDN_HEADS), 64);
    LAUNCH(k_merged, (size_t)NTOK * D_MODEL, 256);
    LAUNCH(k_out, (size_t)NTOK * D_MODEL, 256);
    LAUNCH(k_final, NTOK, 64);
}

#ifdef HOST_EMU
int main() {
    FILE* f = fopen("small_in.bin", "rb"); std::vector<std::vector<float>> in(20); void* d_in[20]; int sizes[20];
    for (int i = 0; i < 20; ++i) { int n; if (fread(&n, 4, 1, f) != 1) return 1; in[i].resize(n); if (fread(in[i].data(), 4, n, f) != (size_t)n) return 1; d_in[i] = in[i].data(); sizes[i] = n; }
    fclose(f);
    size_t nout = (size_t)NTOK * D_MODEL; std::vector<float> out(nout), ref(nout);
    f = fopen("small_out.bin", "rb"); if (fread(ref.data(), 4, nout, f) != nout) return 1; fclose(f);
    size_t wsz = 64u << 20; std::vector<char> ws(wsz, (char)0xAA);
    kernel_launch(d_in, sizes, 20, out.data(), (int)nout, ws.data(), wsz, nullptr);
    double num = 0, den = 0, mx = 0; for (size_t i = 0; i < nout; ++i) { double d = (double)out[i] - ref[i]; num += d * d; den += (double)ref[i] * ref[i]; if (fabs(d) > mx) mx = fabs(d); }
    printf("rvr %.3e absmax %.3e\n", num / den, mx);
    return 0;
}
#endif
```

```cpp
#include <hip/hip_runtime.h>
#include <cstdio>
#include <cstdint>
namespace pg8 {
#define PG8_LAS __attribute__((address_space(3)))
typedef unsigned short bf16_t;
typedef short bf16x8 __attribute__((ext_vector_type(8)));
typedef float f32x4 __attribute__((ext_vector_type(4)));
typedef unsigned u32x4 __attribute__((ext_vector_type(4)));
constexpr int BM = 256, BK = 64, HALF = 128, HTB = HALF * BK * 2  , STAGE_BYTES = 8 * HTB, NXCD = 8, WGM = 8;

__host__ __device__ __forceinline__ int lds_byte(int r, int c) { const int st = (r >> 4) * 2 + (c >> 5), rr = r & 15, cc = c & 31, ob = rr * 64 + cc * 2; return st * 1024 + (ob ^ (((ob >> 9) & 1) << 5)); }
__host__ __device__ __forceinline__ void stage_rc(int b, int& R, int& C) { const int st = b / 1024, sb = b % 1024, swz = sb ^ (((sb >> 9) & 1) << 5); R = (st >> 1) * 16 + swz / 64; C = (st & 1) * 32 + (swz % 64) / 2; }
__host__ __device__ __forceinline__ int perm32(int rho) { const int n = rho >> 4, i = rho & 15; return 8 * (i >> 2) + 4 * n + (i & 3); }

struct Unit { int pm, pn; };
struct Gemm { const bf16_t* A; const bf16_t* Bt; int M, N, K; };

struct StaticOrder {
    int nM, nN, nwg, G, c;
    __host__ __device__ void init(int M, int N, int G_, int c_) { nM = M / BM; nN = N / BM; nwg = nM * nN; G = G_; c = c_; }
    __host__ __device__ bool next(int i, Unit& u) const {
        const long L = (long)i * G + c; if (L >= nwg) return false;
        int wgid = (int)L; { const int q = nwg / NXCD, r = nwg % NXCD, xcd = wgid % NXCD, off = wgid / NXCD; wgid = (xcd < r ? xcd * (q + 1) : r * (q + 1) + (xcd - r) * q) + off; }
        const int nig = WGM * nN, gid = wgid / nig, fm = gid * WGM, gsz = (nM - fm) < WGM ? (nM - fm) : WGM;
        u.pm = fm + ((wgid % nig) % gsz); u.pn = (wgid % nig) / gsz; return true;
    }
    __device__ __forceinline__ void a_ready(const Unit&) const {}
    __device__ __forceinline__ void done(const Unit&) const {}
};

__device__ __forceinline__ unsigned cvt_pk_bf16(float lo, float hi) { unsigned r; asm volatile("v_cvt_pk_bf16_f32 %0, %1, %2" : "=v"(r) : "v"(lo), "v"(hi)); return r; }
typedef float f32x2 __attribute__((ext_vector_type(2)));
__device__ __forceinline__ f32x2 gelu_pk(f32x2 v) {
    const f32x2 av = __builtin_elementwise_abs(v), d = av * 0.2316418882f + 1.0f;
    f32x2 t; t.x = __builtin_amdgcn_rcpf(d.x); t.y = __builtin_amdgcn_rcpf(d.y);
    f32x2 q = t * 0.5307027145f + (-0.7265760135f); q = q * t + 0.7107068705f; q = q * t + (-0.142248368f); q = q * t + 0.127414796f; q = q * t;
    const f32x2 s = (v * v) * (-0.72134752044f);
    f32x2 e; e.x = __builtin_amdgcn_exp2f(s.x); e.y = __builtin_amdgcn_exp2f(s.y);
    const f32x2 m = v * (q * e), r = v - m;
    f32x2 o; o.x = v.x < 0.f ? m.x : r.x; o.y = v.y < 0.f ? m.y : r.y; return o;
}

template <int ACT  > struct EpiBf16 {
    static constexpr bool PERM = true, AFTER_DRAIN = false; static_assert(ACT == 0 || ACT == 1, "EpiBf16: ACT is 0 (none) or 1 (gelu_pk)");
    bf16_t* O; int ldc; const float* bias; int split_cols; size_t split_stride; float scale0;
    __device__ __forceinline__ void operator()(const f32x4 (&acc)[2][2][4][2], const Unit& u, int wr, int wc, int fr, int fq) const {
        const int row0 = u.pm * BM + wr * 64 + fr; int colt = u.pn * BM; bf16_t* base = O;
        float sc = 1.f; if (split_cols) { const int t = colt / split_cols; base += (size_t)t * split_stride; colt -= t * split_cols; if (t == 0) sc = scale0; }
        const int col0 = colt + wc * 32 + 8 * fq, bcol0 = u.pn * BM + wc * 32 + 8 * fq;
        f32x4 bv[2][2];
#pragma unroll
        for (int bj = 0; bj < 2; ++bj)
#pragma unroll
            for (int n = 0; n < 2; ++n) bv[bj][n] = bias ? *(const f32x4*)(bias + bcol0 + bj * HALF + 4 * n) : (f32x4){0.f, 0.f, 0.f, 0.f};
#pragma unroll
        for (int ai = 0; ai < 2; ++ai)
#pragma unroll
            for (int m = 0; m < 4; ++m) { bf16_t* rowp = base + (size_t)(row0 + ai * HALF + m * 16) * ldc + col0;
#pragma unroll
                for (int bj = 0; bj < 2; ++bj) { f32x4 v0 = acc[ai][bj][m][0] + bv[bj][0], v1 = acc[ai][bj][m][1] + bv[bj][1];
                    if (ACT == 1) { f32x2 a = gelu_pk((f32x2){v0[0], v0[1]}), b = gelu_pk((f32x2){v0[2], v0[3]}), c = gelu_pk((f32x2){v1[0], v1[1]}), d = gelu_pk((f32x2){v1[2], v1[3]});
                        v0 = (f32x4){a.x, a.y, b.x, b.y}; v1 = (f32x4){c.x, c.y, d.x, d.y}; }
                    v0 = v0 * sc; v1 = v1 * sc; u32x4 w; w.x = cvt_pk_bf16(v0[0], v0[1]); w.y = cvt_pk_bf16(v0[2], v0[3]); w.z = cvt_pk_bf16(v1[0], v1[1]); w.w = cvt_pk_bf16(v1[2], v1[3]);
                    *(u32x4*)(rowp + bj * HALF) = w; } }
    }
};

template <class Epi, class Sched, bool ALIGN_EPI = false, bool SP2 = false>
__device__ __forceinline__ void gemm_phase(PG8_LAS unsigned char* lds, const Gemm g, const Sched& S, const Epi& E) {
    const int tid = threadIdx.x, wid = __builtin_amdgcn_readfirstlane(tid >> 6), lane = tid & 63, wr = wid >> 2, wc = wid & 3, fr = lane & 15, fq = lane >> 4;
    const int K = g.K, nt = K / BK;
    unsigned voffA[2], voffB[2];
#pragma unroll
    for (int i = 0; i < 2; ++i) { int R, C; stage_rc(tid * 16 + i * 8192, R, C); const int Rb = Epi::PERM ? ((R & ~31) + perm32(R & 31)) : R;
        voffA[i] = (unsigned)(R * K + C) * 2u; voffB[i] = (unsigned)(Rb * K + C) * 2u; }
    const size_t kstep = (size_t)(BK * 2);
    const size_t hstep = (size_t)HALF * K * 2;
    const size_t tstep = 2 * hstep;
    const unsigned ldsw = (unsigned)wid * 1024u;
    const int aoff = lds_byte(wr * 64 + fr, fq * 8), boff = lds_byte(wc * 32 + fr, fq * 8);
#define PG8_SA(b, h) (((b) * 2 + (h)) * HTB)
#define PG8_SB(b, h) ((4 + (b) * 2 + (h)) * HTB)
#define PG8_STAGE(bufoff, gbase, voff) do { _Pragma("unroll") for (int _i = 0; _i < 2; ++_i) \
        __builtin_amdgcn_global_load_lds((const unsigned*)((const char*)(gbase) + (voff)[_i]), (PG8_LAS unsigned*)(lds + (bufoff) + ldsw + _i * 8192), 16, 0, 0); } while (0)
#define PG8_LDA(dst, b, h) do { _Pragma("unroll") for (int m = 0; m < 4; ++m) _Pragma("unroll") for (int k = 0; k < 2; ++k) dst[m][k] = *(const PG8_LAS bf16x8*)(lds + PG8_SA(b, h) + aoff + m * 2048 + k * 1024); } while (0)
#define PG8_LDB(dst, b, h) do { _Pragma("unroll") for (int n = 0; n < 2; ++n) _Pragma("unroll") for (int k = 0; k < 2; ++k) dst[n][k] = *(const PG8_LAS bf16x8*)(lds + PG8_SB(b, h) + boff + n * 2048 + k * 1024); } while (0)
#define PG8_MMA(ai, bj, At, Bt) do { __builtin_amdgcn_s_setprio(1); _Pragma("unroll") for (int m = 0; m < 4; ++m) _Pragma("unroll") for (int n = 0; n < 2; ++n) _Pragma("unroll") for (int k = 0; k < 2; ++k) \
        acc[ai][bj][m][n] = __builtin_amdgcn_mfma_f32_16x16x32_bf16(Bt[n][k], At[m][k], acc[ai][bj][m][n], 0, 0, 0); __builtin_amdgcn_s_setprio(0); } while (0)
#define PG8_WAIT_V(n) asm volatile("s_waitcnt vmcnt(" #n ")" ::: "memory")
#define PG8_WAIT_L(n) asm volatile("s_waitcnt lgkmcnt(" #n ")" ::: "memory")
#define PG8_BAR __builtin_amdgcn_s_barrier()
#define PG8_SCHED __builtin_amdgcn_sched_barrier(0)
    Unit cur, nxt; int ui = 0;
    if (!S.next(0, cur)) return;
    f32x4 acc[2][2][4][2];
#pragma unroll
    for (int a = 0; a < 2; ++a)
#pragma unroll
        for (int b = 0; b < 2; ++b)
#pragma unroll
            for (int m = 0; m < 4; ++m)
#pragma unroll
                for (int n = 0; n < 2; ++n) acc[a][b][m][n] = (f32x4){0.f, 0.f, 0.f, 0.f};
    bf16x8 At[4][2], B0[2][2], B1[2][2];
    const char* cA = (const char*)g.A + (size_t)cur.pm * tstep; const char* cB = (const char*)g.Bt + (size_t)cur.pn * tstep;
    S.a_ready(cur);
    if constexpr (SP2) {
        PG8_STAGE(PG8_SB(0, 0), cB, voffB); PG8_STAGE(PG8_SB(0, 1), cB + hstep, voffB); PG8_STAGE(PG8_SA(0, 0), cA, voffA); PG8_STAGE(PG8_SA(0, 1), cA + hstep, voffA);
        if (wr == 1) PG8_BAR;
        PG8_WAIT_V(2); PG8_BAR;
        PG8_STAGE(PG8_SB(1, 0), cB + kstep, voffB); PG8_STAGE(PG8_SA(1, 0), cA + kstep, voffA); PG8_STAGE(PG8_SB(1, 1), cB + hstep + kstep, voffB);
        PG8_WAIT_V(6); PG8_BAR;
    } else {
        PG8_STAGE(PG8_SB(0, 0), cB, voffB); PG8_STAGE(PG8_SA(0, 0), cA, voffA); PG8_STAGE(PG8_SB(0, 1), cB + hstep, voffB); PG8_STAGE(PG8_SA(0, 1), cA + hstep, voffA);
        if (wr == 1) PG8_BAR;
        PG8_WAIT_V(4); PG8_BAR;
        PG8_STAGE(PG8_SB(1, 0), cB + kstep, voffB); PG8_STAGE(PG8_SA(1, 0), cA + kstep, voffA); PG8_STAGE(PG8_SB(1, 1), cB + hstep + kstep, voffB);
        PG8_WAIT_V(6); PG8_BAR;
    }
    for (;;) {
        const bool has_next = S.next(ui + 1, nxt);
        const char* nA = has_next ? (const char*)g.A + (size_t)nxt.pm * tstep : cA; const char* nB = has_next ? (const char*)g.Bt + (size_t)nxt.pn * tstep : cB;
        for (int t = 0; t < nt; t += 2) {
            const bool last = (t == nt - 2);
            const char* a1 = cA + (size_t)(t + 1) * kstep;
            const char* a2 = last ? nA : cA + (size_t)(t + 2) * kstep; const char* b2 = last ? nB : cB + (size_t)(t + 2) * kstep;
            const char* a3 = a2 + kstep; const char* b3 = b2 + kstep;
            if (last && has_next) S.a_ready(nxt);
            if constexpr (SP2) {
            PG8_LDB(B0, 0, 0); PG8_LDB(B1, 0, 1); PG8_SCHED; PG8_LDA(At, 0, 0); PG8_STAGE(PG8_SA(1, 1), a1 + hstep, voffA);
            PG8_WAIT_V(8); PG8_WAIT_L(0); PG8_BAR; PG8_MMA(0, 0, At, B0); PG8_MMA(0, 1, At, B1); PG8_BAR; PG8_SCHED;
            PG8_LDA(At, 0, 1); PG8_STAGE(PG8_SB(0, 0), b2, voffB); PG8_STAGE(PG8_SB(0, 1), b2 + hstep, voffB); PG8_STAGE(PG8_SA(0, 0), a2, voffA);
            PG8_WAIT_V(8); PG8_WAIT_L(0); PG8_BAR; PG8_MMA(1, 0, At, B0); PG8_MMA(1, 1, At, B1); PG8_BAR; PG8_SCHED;
            PG8_LDB(B0, 1, 0); PG8_LDB(B1, 1, 1); PG8_SCHED; PG8_LDA(At, 1, 0); PG8_STAGE(PG8_SA(0, 1), a2 + hstep, voffA);
            PG8_WAIT_V(8); PG8_WAIT_L(0); PG8_BAR; PG8_MMA(0, 0, At, B0); PG8_MMA(0, 1, At, B1); PG8_BAR; PG8_SCHED;
            PG8_LDA(At, 1, 1); PG8_STAGE(PG8_SB(1, 0), b3, voffB); PG8_STAGE(PG8_SB(1, 1), b3 + hstep, voffB); PG8_STAGE(PG8_SA(1, 0), a3, voffA);
            PG8_WAIT_V(8); PG8_WAIT_L(0); PG8_BAR; PG8_MMA(1, 0, At, B0); PG8_MMA(1, 1, At, B1); PG8_BAR; PG8_SCHED;
            } else {
            PG8_LDB(B0, 0, 0); PG8_SCHED; PG8_LDA(At, 0, 0); PG8_STAGE(PG8_SA(1, 1), a1 + hstep, voffA);
            PG8_WAIT_L(8); PG8_BAR; PG8_WAIT_L(0); PG8_MMA(0, 0, At, B0); PG8_BAR; PG8_SCHED;
            PG8_LDB(B1, 0, 1); PG8_STAGE(PG8_SB(0, 0), b2, voffB);
            PG8_BAR; PG8_WAIT_L(0); PG8_MMA(0, 1, At, B1); PG8_BAR;
            PG8_LDA(At, 0, 1); PG8_STAGE(PG8_SA(0, 0), a2, voffA);
            PG8_BAR; PG8_WAIT_L(0); PG8_MMA(1, 0, At, B0); PG8_BAR; PG8_SCHED;
            PG8_STAGE(PG8_SB(0, 1), b2 + hstep, voffB);
            PG8_WAIT_V(6); PG8_BAR; PG8_MMA(1, 1, At, B1); PG8_BAR;
            PG8_LDB(B0, 1, 0); PG8_SCHED; PG8_LDA(At, 1, 0); PG8_STAGE(PG8_SA(0, 1), a2 + hstep, voffA);
            PG8_WAIT_L(8); PG8_BAR; PG8_WAIT_L(0); PG8_MMA(0, 0, At, B0); PG8_BAR; PG8_SCHED;
            PG8_LDB(B1, 1, 1); PG8_STAGE(PG8_SB(1, 0), b3, voffB);
            PG8_BAR; PG8_WAIT_L(0); PG8_MMA(0, 1, At, B1); PG8_BAR;
            PG8_LDA(At, 1, 1); PG8_STAGE(PG8_SA(1, 0), a3, voffA);
            PG8_BAR; PG8_WAIT_L(0); PG8_MMA(1, 0, At, B0); PG8_BAR; PG8_SCHED;
            PG8_STAGE(PG8_SB(1, 1), b3 + hstep, voffB);
            PG8_WAIT_V(6); PG8_BAR; PG8_MMA(1, 1, At, B1); PG8_BAR;
            }
        }
        if constexpr (ALIGN_EPI) { if (wr == 0) PG8_BAR; }
        if constexpr (!Epi::AFTER_DRAIN) { E(acc, cur, wr, wc, fr, fq); S.done(cur); }
        if (!has_next) break;
#pragma unroll
        for (int a = 0; a < 2; ++a)
#pragma unroll
            for (int b = 0; b < 2; ++b)
#pragma unroll
                for (int m = 0; m < 4; ++m)
#pragma unroll
                    for (int n = 0; n < 2; ++n) acc[a][b][m][n] = (f32x4){0.f, 0.f, 0.f, 0.f};
        cur = nxt; cA = nA; cB = nB; ++ui;
        if constexpr (ALIGN_EPI) { if (wr == 1) PG8_BAR; }
    }
    PG8_WAIT_V(0);
    if constexpr (!ALIGN_EPI) { if (wr == 0) PG8_BAR; }
    PG8_BAR;
    if constexpr (Epi::AFTER_DRAIN) { E.fused(acc, cur, wr, wc, fr, fq, lds, wid, lane); S.done(cur); }
#undef PG8_SA
#undef PG8_SB
#undef PG8_STAGE
#undef PG8_LDA
#undef PG8_LDB
#undef PG8_MMA
#undef PG8_WAIT_V
#undef PG8_WAIT_L
#undef PG8_BAR
#undef PG8_SCHED
}
}
#define PG8_SP2 true
#define PG8_ALIGN true
constexpr int NWAVES = 8;
constexpr int BATCH = 8, SEQ = 2048, DM = 1024, CTXL = 256, NTOK = BATCH * SEQ, NCTX = BATCH * CTXL, NROWS = NTOK + NCTX;
constexpr int C_ALR = 1536, C_BQ = 1568, C_BG = 3104, C_BBETA = 3616, C_MG = 3632, D_IN = 5680;
constexpr int NIN = 5888;
constexpr int NSM = 48;
constexpr float EPSV = 1e-6f;
constexpr size_t MiB = 1u << 20;
constexpr size_t WS_CTL = 0, CTL_ZERO_BYTES = 1 * MiB;
constexpr int CW_BAR = 4096;
constexpr size_t WS_MOD = 64 * 1024, WS_ROWSS = 256 * 1024;
constexpr size_t WS_WTIN = 2 * MiB, WS_WTGA = 14 * MiB, WS_WTGD = 15 * MiB, WS_WTO = 16 * MiB;
constexpr size_t WS_H = 18 * MiB, WS_AQ = 54 * MiB, WS_AK = 62 * MiB, WS_AV = 71 * MiB, WS_PRE = 89 * MiB, WS_SM = 143 * MiB, WS_AG = 147 * MiB, WS_BG = 163 * MiB, WS_POST = 179 * MiB, WS_YB = 233 * MiB;
constexpr size_t WS_OAF = 18 * MiB, WS_OAB = 34 * MiB, WS_OBF = 89 * MiB, WS_OBB = 105 * MiB, WS_YA = 121 * MiB;
constexpr size_t WS_TMP = 18 * MiB, WS_MERGED = 179 * MiB, WS_END = 249 * MiB;
constexpr int LDS_BYTES = 147456;
constexpr int MISC_OFF = 131072 + 320;

#define GAS __attribute__((address_space(1)))
#define LAS __attribute__((address_space(3)))
typedef unsigned short bf16;
typedef unsigned v4u __attribute__((ext_vector_type(4)));
typedef unsigned v2u __attribute__((ext_vector_type(2)));
typedef float f32x4 __attribute__((ext_vector_type(4)));
#define LDS_WAIT() asm volatile("s_waitcnt lgkmcnt(0)" ::: "memory")
#define VM_WAIT() asm volatile("s_waitcnt vmcnt(0)" ::: "memory")
__device__ __forceinline__ unsigned f2bf(float f) { unsigned u = __builtin_bit_cast(unsigned, f); return (u + 0x7fffu + ((u >> 16) & 1u)) >> 16; }
__device__ __forceinline__ unsigned pk2(float lo, float hi) { return f2bf(lo) | (f2bf(hi) << 16); }
__device__ __forceinline__ float bflo(unsigned w) { return __builtin_bit_cast(float, w << 16); }
__device__ __forceinline__ float bfhi(unsigned w) { return __builtin_bit_cast(float, w & 0xffff0000u); }
__device__ __forceinline__ float bf2f(bf16 b) { return __builtin_bit_cast(float, ((unsigned)b) << 16); }
__device__ __forceinline__ float fsigm(float x) { return __builtin_amdgcn_rcpf(1.f + __expf(-x)); }
__device__ __forceinline__ float fsilu(float x) { return x * fsigm(x); }
__device__ __forceinline__ float softplusf_(float x) { return fmaxf(x, 0.f) + log1pf(expf(-fabsf(x))); }
__device__ __forceinline__ float logsigf_(float x) { return fminf(x, 0.f) - log1pf(expf(-fabsf(x))); }
__device__ __forceinline__ void unpack8(v4u w, float (&v)[8]) { v[0] = bflo(w.x); v[1] = bfhi(w.x); v[2] = bflo(w.y); v[3] = bfhi(w.y); v[4] = bflo(w.z); v[5] = bfhi(w.z); v[6] = bflo(w.w); v[7] = bfhi(w.w); }
__device__ __forceinline__ v4u pack8(const float (&v)[8]) { v4u w; w.x = pk2(v[0], v[1]); w.y = pk2(v[2], v[3]); w.z = pk2(v[4], v[5]); w.w = pk2(v[6], v[7]); return w; }
__device__ __forceinline__ float wave_sum(float v) {
#pragma unroll
    for (int o = 1; o < 64; o <<= 1) v += __shfl_xor(v, o);
    return v;
}
__device__ __forceinline__ float grp16_sum(float v) {
#pragma unroll
    for (int o = 1; o < 16; o <<= 1) v += __shfl_xor(v, o);
    return v;
}

#define XB_TMO      128
#define XB_XCNT(j)  (256  + 64 * (j))
#define XB_XSUB(j)  (1280 + 64 * (j))
#define XB_XGEN(j)  (2304 + 64 * (j))
#define XB_TOP      3328
#define XB_TOPGEN   3392
#define XCD_BAR_WORDS 3456
#define XB_SPIN_CAP (1u << 22)
__device__ __forceinline__ unsigned xb_ld(unsigned* p)              { return __hip_atomic_load(p, __ATOMIC_RELAXED, __HIP_MEMORY_SCOPE_AGENT); }
__device__ __forceinline__ unsigned xb_add(unsigned* p, unsigned v) { return __hip_atomic_fetch_add(p, v, __ATOMIC_RELAXED, __HIP_MEMORY_SCOPE_AGENT); }
__device__ __forceinline__ unsigned xb_xcc_id() { return (unsigned)__builtin_amdgcn_s_getreg((3 << 11) | 20) & 0xFu; }
#define XB_SPIN(cond, bar) do { unsigned _sp = 0; while (cond) { __builtin_amdgcn_s_sleep(1); \
    if ((++_sp & 255u) == 0u) { if (xb_ld(&(bar)[XB_TMO])) break; if (_sp > XB_SPIN_CAP) { atomicAdd(&(bar)[XB_TMO], 1u); break; } } } } while (0)
struct XcdBarrier { unsigned* bar; unsigned x; volatile LAS unsigned* st; };
__device__ __forceinline__ XcdBarrier xcd_barrier_post(unsigned* bar, volatile LAS unsigned* st) {
    XcdBarrier b; b.bar = bar; b.x = xb_xcc_id(); b.st = st;
    if (threadIdx.x == 0) (void)xb_add(&bar[XB_XCNT(b.x)], 1u);
    return b;
}
__device__ __forceinline__ void xcd_barrier_complete(unsigned* bar, unsigned x, unsigned& nloc, unsigned& nx) {
    const unsigned G = gridDim.x * gridDim.y * gridDim.z;
    unsigned sum, cnt, mine, sp = 0u;
    for (;;) {
        sum = 0u; cnt = 0u; mine = 0u;
#pragma unroll
        for (unsigned j = 0; j < 16; ++j) { const unsigned c = xb_ld(&bar[XB_XCNT(j)]); sum += c; cnt += (c > 0u) ? 1u : 0u; mine = (j == x) ? c : mine; }
        if (sum == G) break;
        __builtin_amdgcn_s_sleep(1);
        if ((++sp & 255u) == 0u) { if (xb_ld(&bar[XB_TMO])) break; if (sp > XB_SPIN_CAP) { atomicAdd(&bar[XB_TMO], 1u); break; } }
    }
    nloc = mine > 0u ? mine : 1u; nx = cnt > 0u ? cnt : 1u;
}
__device__ __forceinline__ void xcd_barrier(const XcdBarrier& b) {
    asm volatile("s_waitcnt vmcnt(0)" ::: "memory");
    __syncthreads();
    if (threadIdx.x == 0) {
        unsigned* bar = b.bar;
        __builtin_amdgcn_s_waitcnt(0);
        unsigned nloc = b.st[0], nx = b.st[1];
        if (nloc == 0u) { xcd_barrier_complete(bar, b.x, nloc, nx); b.st[0] = nloc; b.st[1] = nx; }
        const unsigned old = xb_add(&bar[XB_XSUB(b.x)], 1u);
        const unsigned gen = old / nloc;
        if (old + 1u == (gen + 1u) * nloc) {
            __builtin_amdgcn_fence(__ATOMIC_RELEASE, "agent");
            asm volatile("s_waitcnt vmcnt(0)" ::: "memory");
            const unsigned og = xb_add(&bar[XB_TOP], 1u);
            const unsigned tg = og / nx;
            if (og + 1u == (tg + 1u) * nx) xb_add(&bar[XB_TOPGEN], 1u);
            else XB_SPIN(xb_ld(&bar[XB_TOPGEN]) == tg, bar);
            __builtin_amdgcn_fence(__ATOMIC_ACQUIRE, "agent");
            xb_add(&bar[XB_XGEN(b.x)], 1u);
            asm volatile("s_waitcnt vmcnt(0)" ::: "memory");
        } else {
            XB_SPIN(xb_ld(&bar[XB_XGEN(b.x)]) == gen, bar);
            __builtin_amdgcn_fence(__ATOMIC_ACQUIRE, "agent");
            asm volatile("s_waitcnt vmcnt(0)" ::: "memory");
        }
    }
    __syncthreads();
}

namespace pg8 {
struct EpiIn {
    static constexpr bool PERM = true, AFTER_DRAIN = false;
    unsigned char* ws; bf16* GATES; float* SM; const float* b_gate;
    __device__ __forceinline__ void operator()(const f32x4 (&acc)[2][2][4][2], const Unit& u, int wr, int wc, int fr, int fq) const {
        const int pn = u.pn, row0 = u.pm * BM + wr * 64 + fr; const bool lat = u.pm < NTOK / BM;
        if (pn == 10) {
            if (wc > 1 || (wc == 1 && fq >= 2)) return;
            const int c0 = wc * 32 + 8 * fq;
#pragma unroll
            for (int ai = 0; ai < 2; ++ai)
#pragma unroll
                for (int m = 0; m < 4; ++m) { float* rp = SM + (size_t)(row0 + ai * HALF + m * 16) * NSM + c0;
                    *(f32x4*)rp = acc[ai][0][m][0]; *(f32x4*)(rp + 4) = acc[ai][0][m][1]; }
            return;
        }
        size_t boff; int ld, cb, act = 0; float sc = 1.f; bool latonly = false;
        if (pn == 0) { boff = WS_AQ; ld = 256; cb = 0; sc = 0.125f; latonly = true; }
        else if (pn == 1) { boff = WS_AK; ld = 256; cb = 0; }
        else if (pn < 4) { boff = WS_AV; ld = 512; cb = (pn - 2) * 256; }
        else if (pn < 10) { boff = WS_PRE; ld = 1536; cb = (pn - 4) * 256; }
        else if (pn < 13) { boff = WS_AG; ld = 512; cb = (pn - 11) * 256; act = 1; latonly = true; }
        else if (pn < 15) { boff = WS_BG; ld = 512; cb = (pn - 13) * 256; act = 1; latonly = true; }
        else { boff = 0; ld = 2048; cb = (pn - 15) * 256; act = 2; latonly = true; }
        bf16* base = (pn >= 15) ? GATES : (bf16*)(ws + boff);
        if (latonly && !lat) return;
        const int col0 = cb + wc * 32 + 8 * fq;
#pragma unroll
        for (int ai = 0; ai < 2; ++ai)
#pragma unroll
            for (int m = 0; m < 4; ++m) { bf16* rowp = base + (size_t)(row0 + ai * HALF + m * 16) * ld + col0;
#pragma unroll
                for (int bj = 0; bj < 2; ++bj) { f32x4 v0 = acc[ai][bj][m][0], v1 = acc[ai][bj][m][1];
                    if (act == 1) {
#pragma unroll
                        for (int j = 0; j < 4; ++j) { v0[j] = fsilu(v0[j]); v1[j] = fsilu(v1[j]); } }
                    else if (act == 2) { const f32x4 b0 = *(const f32x4*)(b_gate + col0 + bj * HALF), b1 = *(const f32x4*)(b_gate + col0 + bj * HALF + 4);
#pragma unroll
                        for (int j = 0; j < 4; ++j) { v0[j] = fsigm(v0[j] + b0[j]); v1[j] = fsigm(v1[j] + b1[j]); } }
                    else { v0 = v0 * sc; v1 = v1 * sc; }
                    u32x4 w; w.x = cvt_pk_bf16(v0[0], v0[1]); w.y = cvt_pk_bf16(v0[2], v0[3]); w.z = cvt_pk_bf16(v1[0], v1[1]); w.w = cvt_pk_bf16(v1[2], v1[3]);
                    *(u32x4*)(rowp + bj * HALF) = w; } }
    }
};
struct EpiGa {
    static constexpr bool PERM = true, AFTER_DRAIN = false;
    const bf16* GATES; float* TMP;
    __device__ __forceinline__ void operator()(const f32x4 (&acc)[2][2][4][2], const Unit& u, int wr, int wc, int fr, int fq) const {
        const int row0 = u.pm * BM + wr * 64 + fr, col0 = u.pn * BM + wc * 32 + 8 * fq;
#pragma unroll
        for (int ai = 0; ai < 2; ++ai)
#pragma unroll
            for (int m = 0; m < 4; ++m) { const size_t r = (size_t)(row0 + ai * HALF + m * 16);
#pragma unroll
                for (int bj = 0; bj < 2; ++bj) { const u32x4 g = *(const u32x4*)(GATES + r * 2048 + col0 + bj * HALF); float gv[8]; unpack8((v4u)g, gv);
                    f32x4 v0 = acc[ai][bj][m][0], v1 = acc[ai][bj][m][1];
#pragma unroll
                    for (int j = 0; j < 4; ++j) { v0[j] *= gv[j]; v1[j] *= gv[4 + j]; }
                    float* tp = TMP + r * 1024 + col0 + bj * HALF; *(f32x4*)tp = v0; *(f32x4*)(tp + 4) = v1; } }
    }
};
struct EpiGb {
    static constexpr bool PERM = true, AFTER_DRAIN = false;
    const bf16* GATES; const float* TMP; bf16* MERGED;
    __device__ __forceinline__ void operator()(const f32x4 (&acc)[2][2][4][2], const Unit& u, int wr, int wc, int fr, int fq) const {
        const int row0 = u.pm * BM + wr * 64 + fr, col0 = u.pn * BM + wc * 32 + 8 * fq;
#pragma unroll
        for (int ai = 0; ai < 2; ++ai)
#pragma unroll
            for (int m = 0; m < 4; ++m) { const size_t r = (size_t)(row0 + ai * HALF + m * 16);
#pragma unroll
                for (int bj = 0; bj < 2; ++bj) { const u32x4 g = *(const u32x4*)(GATES + r * 2048 + 1024 + col0 + bj * HALF); float gv[8]; unpack8((v4u)g, gv);
                    const float* tp = TMP + r * 1024 + col0 + bj * HALF; f32x4 v0 = *(const f32x4*)tp, v1 = *(const f32x4*)(tp + 4);
#pragma unroll
                    for (int j = 0; j < 4; ++j) { v0[j] += gv[j] * acc[ai][bj][m][0][j]; v1[j] += gv[4 + j] * acc[ai][bj][m][1][j]; }
                    u32x4 w; w.x = cvt_pk_bf16(v0[0], v0[1]); w.y = cvt_pk_bf16(v0[2], v0[3]); w.z = cvt_pk_bf16(v1[0], v1[1]); w.w = cvt_pk_bf16(v1[2], v1[3]);
                    *(u32x4*)(MERGED + r * 1024 + col0 + bj * HALF) = w; } }
    }
};
struct EpiOut {
    static constexpr bool PERM = true, AFTER_DRAIN = false;
    const float* x; const float* MOD; float* out; float* ROWSS;
    __device__ __forceinline__ void operator()(const f32x4 (&acc)[2][2][4][2], const Unit& u, int wr, int wc, int fr, int fq) const {
        const int row0 = u.pm * BM + wr * 64 + fr, col0 = u.pn * BM + wc * 32 + 8 * fq;
        const float* gt = MOD + (size_t)(u.pm * BM / SEQ) * 3072 + 2048 + col0;
        f32x4 g[2][2];
#pragma unroll
        for (int bj = 0; bj < 2; ++bj) { g[bj][0] = *(const f32x4*)(gt + bj * HALF); g[bj][1] = *(const f32x4*)(gt + bj * HALF + 4); }
#pragma unroll
        for (int ai = 0; ai < 2; ++ai)
#pragma unroll
            for (int m = 0; m < 4; ++m) { const size_t r = (size_t)(row0 + ai * HALF + m * 16); float ss = 0.f;
#pragma unroll
                for (int bj = 0; bj < 2; ++bj) { const float* xp = x + r * 1024 + col0 + bj * HALF; float* op = out + r * 1024 + col0 + bj * HALF;
                    f32x4 y0 = *(const f32x4*)xp + g[bj][0] * acc[ai][bj][m][0], y1 = *(const f32x4*)(xp + 4) + g[bj][1] * acc[ai][bj][m][1];
                    *(f32x4*)op = y0; *(f32x4*)(op + 4) = y1;
                    ss += (y0[0] * y0[0] + y0[1] * y0[1]) + (y0[2] * y0[2] + y0[3] * y0[3]) + (y1[0] * y1[0] + y1[1] * y1[1]) + (y1[2] * y1[2] + y1[3] * y1[3]); }
                ss += __shfl_xor(ss, 16); ss += __shfl_xor(ss, 32);
                if (fq == 0) atomicAdd(ROWSS + r, ss); }
    }
};
}

struct Args { const float* in[20]; float* out; unsigned char* ws; };
struct Frame {
    LAS unsigned char* lds; volatile LAS unsigned* MISC; unsigned* ctl;
    int tid, lane, wave, vcu, G, gw, NGW;
    const float *x, *c, *ctx, *c_ctx, *w_mod, *b_mod, *norm_g, *w_in, *gla_up, *gla_ub, *gla_onorm, *gdn_conv, *gdn_a_log, *gdn_dt_bias, *gdn_onorm, *w_gla_out, *w_gdn_out, *b_gate, *w_o, *final_g;
    float* out; unsigned char* ws;
};

__device__ __forceinline__ int in_src_col(int d) {
    if (d < 1024) return d;
    if (d < 2560) return C_BQ + (d - 1024);
    if (d < 2592) return C_ALR + (d - 2560);
    if (d < 2608) return C_BBETA + (d - 2592);
    if (d < 2816) return -1;
    if (d < 3328) return 1024 + (d - 2816);
    if (d < 3840) return C_BG + (d - 3328);
    return C_MG + (d - 3840);
}
template <bool MAP>
__device__ __forceinline__ void p0_transpose_item(const float* W, int K, int ldw, int nblk, bf16* WT, LAS float* scr, int item, int lane) {
    const int kb = item / nblk, nb = item % nblk, k0 = 64 * kb, n0 = 32 * nb;
    const int sc = MAP ? in_src_col(n0 + (lane & 31)) : n0 + (lane & 31);
#pragma unroll 8
    for (int i = 0; i < 32; ++i) { const int kk = 2 * i + (lane >> 5); scr[kk * 33 + (lane & 31)] = sc >= 0 ? W[(size_t)(k0 + kk) * ldw + sc] : 0.f; }
    LDS_WAIT(); asm volatile("" ::: "memory");
    const int c = lane & 7;
#pragma unroll
    for (int j = 0; j < 4; ++j) { const int n = (lane >> 3) + 8 * j; const LAS float* s = scr + (8 * c) * 33 + n;
        v4u o; o.x = pk2(s[0 * 33], s[1 * 33]); o.y = pk2(s[2 * 33], s[3 * 33]); o.z = pk2(s[4 * 33], s[5 * 33]); o.w = pk2(s[6 * 33], s[7 * 33]);
        *(GAS v4u*)(WT + (size_t)(n0 + n) * K + k0 + 8 * c) = o; }
    LDS_WAIT(); asm volatile("" ::: "memory");
}
__device__ __forceinline__ void p0_prologue(Frame& F) {
    LAS float* tab = (LAS float*)(F.lds + 69632);
    for (int i = F.tid; i < 9 * 1024; i += NWAVES * 64) { const int r = i >> 10, k = i & 1023; const float v = r < 8 ? F.c[r * 1024 + k] : F.c_ctx[k]; tab[i] = v / (1.f + __expf(-v)); }
    __syncthreads();
    float* MOD = (float*)(F.ws + WS_MOD);
    for (int it = F.gw; it < 768; it += F.NGW) {
        const int cb = it % 48, ks = it / 48, j = cb * 64 + F.lane; float acc[9];
#pragma unroll
        for (int r = 0; r < 9; ++r) acc[r] = 0.f;
#pragma unroll 8
        for (int kk = 0; kk < 64; ++kk) { const int k = ks * 64 + kk; const float w = F.w_mod[(size_t)k * 3072 + j];
#pragma unroll
            for (int r = 0; r < 9; ++r) acc[r] += tab[r * 1024 + k] * w; }
        const float bias = ks == 0 ? F.b_mod[j] : 0.f;
#pragma unroll
        for (int r = 0; r < 9; ++r) atomicAdd(MOD + r * 3072 + j, acc[r] + bias);
    }
    LAS float* scr = (LAS float*)(F.lds + F.wave * 8704);
    constexpr int I_IN = 16 * (NIN / 32), I_G = 8 * 32, I_O = 16 * 32, NITEMS = I_IN + 2 * I_G + I_O;
    for (int it = F.gw; it < NITEMS; it += F.NGW) {
        int r = it;
        if (r < I_IN) { p0_transpose_item<true>(F.w_in, 1024, D_IN, NIN / 32, (bf16*)(F.ws + WS_WTIN), scr, r, F.lane); continue; } r -= I_IN;
        if (r < I_G) { p0_transpose_item<false>(F.w_gla_out, 512, 1024, 32, (bf16*)(F.ws + WS_WTGA), scr, r, F.lane); continue; } r -= I_G;
        if (r < I_G) { p0_transpose_item<false>(F.w_gdn_out, 512, 1024, 32, (bf16*)(F.ws + WS_WTGD), scr, r, F.lane); continue; } r -= I_G;
        p0_transpose_item<false>(F.w_o, 1024, 1024, 32, (bf16*)(F.ws + WS_WTO), scr, r, F.lane);
    }
}
__device__ __forceinline__ void p1_rows(Frame& F) {
    const float* MOD = (const float*)(F.ws + WS_MOD); bf16* H = (bf16*)(F.ws + WS_H);
    for (int row = F.gw; row < NROWS; row += F.NGW) {
        const float* xr = row < NTOK ? F.x + (size_t)row * DM : F.ctx + (size_t)(row - NTOK) * DM; const int r = row < NTOK ? row / SEQ : BATCH;
        const f32x4* xv = (const f32x4*)xr + F.lane; f32x4 v[4]; float s = 0.f;
#pragma unroll
        for (int j = 0; j < 4; ++j) { v[j] = xv[64 * j]; s += (v[j].x * v[j].x + v[j].y * v[j].y) + (v[j].z * v[j].z + v[j].w * v[j].w); }
        const float rstd = 1.f / sqrtf(wave_sum(s) * (1.f / DM) + EPSV);
        const f32x4* sh = (const f32x4*)(MOD + (size_t)r * 3072) + F.lane; const f32x4* sc = sh + 256; const f32x4* g = (const f32x4*)F.norm_g + F.lane;
        unsigned long long* o8 = (unsigned long long*)(H + (size_t)row * DM) + F.lane;
#pragma unroll
        for (int j = 0; j < 4; ++j) { const f32x4 gg = g[64 * j], cc = sc[64 * j], hh = sh[64 * j]; const f32x4 y = (v[j] * rstd * gg) * (cc + 1.f) + hh;
            o8[64 * j] = (unsigned long long)pk2(y.x, y.y) | ((unsigned long long)pk2(y.z, y.w) << 32); }
    }
}
__device__ __forceinline__ void p3_conv(Frame& F) {
    const bf16* PRE = (const bf16*)(F.ws + WS_PRE); bf16* POST = (bf16*)(F.ws + WS_POST);
    for (int row = F.gw; row < NROWS; row += F.NGW) {
        const bool lat = row < NTOK; int base, t, len;
        if (lat) { base = (row / SEQ) * SEQ; t = row % SEQ; len = SEQ; } else { const int rr = row - NTOK; base = NTOK + (rr / CTXL) * CTXL; t = rr % CTXL; len = CTXL; }
        const int gx = t & 63;
#pragma unroll 1
        for (int wh = 0; wh < 3; ++wh) {
            float acc[8];
#pragma unroll
            for (int e = 0; e < 8; ++e) acc[e] = 0.f;
            const int ch = wh * 512 + 8 * F.lane;
#pragma unroll 1
            for (int dy = (lat ? 0 : 1); dy < (lat ? 3 : 2); ++dy)
#pragma unroll
                for (int dx = 0; dx < 3; ++dx) {
                    int tt; bool ok;
                    if (lat) { const int yy = (t >> 6) + dy - 1, xx = gx + dx - 1; ok = yy >= 0 && yy < SEQ / 64 && xx >= 0 && xx < 64; tt = yy * 64 + xx; }
                    else { tt = t + dx - 1; ok = tt >= 0 && tt < len; }
                    if (!ok) continue;
                    const v4u w = *(const v4u*)(PRE + (size_t)(base + tt) * 1536 + ch); float v[8]; unpack8(w, v);
                    const f32x4* cw = (const f32x4*)(F.gdn_conv + (size_t)(dy * 3 + dx) * 1536 + ch); const f32x4 c0 = cw[0], c1 = cw[1];
#pragma unroll
                    for (int e = 0; e < 4; ++e) { acc[e] += v[e] * c0[e]; acc[4 + e] += v[4 + e] * c1[e]; }
                }
            float ss = 0.f;
#pragma unroll
            for (int e = 0; e < 8; ++e) { acc[e] = fsilu(acc[e]); ss += acc[e] * acc[e]; }
            if (wh < 2) { ss = grp16_sum(ss); float scl = 1.f / sqrtf(ss + EPSV); if (wh == 0) scl *= 0.08838834764831845f;
#pragma unroll
                for (int e = 0; e < 8; ++e) acc[e] *= scl; }
            *(v4u*)(POST + (size_t)row * 1536 + ch) = pack8(acc);
        }
    }
}
__device__ __forceinline__ int scan_row(int b, int dir, int pos, bool& latent) {
    if (pos < CTXL) { latent = false; return NTOK + b * CTXL + (dir ? CTXL - 1 - pos : pos); }
    const int q = pos - CTXL; latent = true; return b * SEQ + (dir ? SEQ - 1 - q : q);
}
__device__ __forceinline__ void p4_scan_naive(Frame& F) {
    const int item = F.vcu; if (item >= 128 || F.tid >= 128) return;
    const int e = F.tid, br = item >> 6, bid = item & 63, dir = bid & 1, h = (bid >> 1) & 3, b = bid >> 3;
    const float* SM = (const float*)(F.ws + WS_SM);
    if (br == 0) {
        const bf16* POST = (const bf16*)(F.ws + WS_POST); bf16* O = (bf16*)(F.ws + (dir ? WS_OBB : WS_OBF));
        float S[128];
#pragma unroll
        for (int d = 0; d < 128; ++d) S[d] = 0.f;
        const float A = -expf(F.gdn_a_log[dir * 4 + h]), dtb = F.gdn_dt_bias[dir * 4 + h];
        for (int pos = 0; pos < CTXL + SEQ; ++pos) {
            bool lat; const int row = scan_row(b, dir, pos, lat);
            const v4u* q = (const v4u*)(POST + (size_t)row * 1536 + h * 128); const v4u* k = (const v4u*)(POST + (size_t)row * 1536 + 512 + h * 128);
            const float v = bf2f(POST[(size_t)row * 1536 + 1024 + h * 128 + e]);
            const float beta = 1.f / (1.f + expf(-SM[(size_t)row * NSM + 32 + dir * 4 + h]));
            const float eg = expf(A * softplusf_(SM[(size_t)row * NSM + 40 + dir * 4 + h] + dtb));
            float ks = 0.f;
#pragma unroll
            for (int c = 0; c < 16; ++c) { float kv[8]; unpack8(k[c], kv); if ((c & 3) == 3) asm volatile("" ::: "memory");
#pragma unroll
                for (int j = 0; j < 8; ++j) ks += kv[j] * S[c * 8 + j]; }
            const float vn = beta * (v - eg * ks); float o = 0.f;
#pragma unroll
            for (int c = 0; c < 16; ++c) { float kv[8], qv[8]; unpack8(k[c], kv); unpack8(q[c], qv); if ((c & 1) == 1) asm volatile("" ::: "memory");
#pragma unroll
                for (int j = 0; j < 8; ++j) { S[c * 8 + j] = eg * S[c * 8 + j] + kv[j] * vn; o += qv[j] * S[c * 8 + j]; } }
            if (lat) O[(size_t)row * 512 + h * 128 + e] = (bf16)f2bf(o);
        }
    } else {
        const bf16* AQ = (const bf16*)(F.ws + WS_AQ); const bf16* AK = (const bf16*)(F.ws + WS_AK); const bf16* AV = (const bf16*)(F.ws + WS_AV); bf16* O = (bf16*)(F.ws + (dir ? WS_OAB : WS_OAF));
        float S[64];
#pragma unroll
        for (int d = 0; d < 64; ++d) S[d] = 0.f;
        for (int pos = 0; pos < CTXL + SEQ; ++pos) {
            bool lat; const int row = scan_row(b, dir, pos, lat);
            const float v = bf2f(AV[(size_t)row * 512 + h * 128 + e]);
            float lr[16];
#pragma unroll
            for (int r = 0; r < 16; ++r) lr[r] = SM[(size_t)row * NSM + dir * 16 + r];
            float o = 0.f; int zo = 0; asm volatile("" : "+v"(zo));
#pragma unroll
            for (int d = 0; d < 64; ++d) {
                float u = F.gla_ub[dir * 256 + h * 64 + d + zo];
#pragma unroll
                for (int r = 0; r < 16; ++r) u += lr[r] * F.gla_up[(size_t)(dir * 16 + r) * 256 + h * 64 + d + zo];
                const float dec = expf(logsigf_(u) * (1.f / 16.f));
                S[d] = dec * S[d] + bf2f(AK[(size_t)row * 256 + h * 64 + d]) * v;
                if (lat) o += bf2f(AQ[(size_t)row * 256 + h * 64 + d]) * S[d];
            }
            if (lat) O[(size_t)row * 512 + h * 128 + e] = (bf16)f2bf(o);
        }
    }
}
__device__ __forceinline__ void p5_y(Frame& F) {
    for (int row = F.gw; row < NTOK; row += F.NGW) {
#pragma unroll
        for (int br = 0; br < 2; ++br) {
            const bf16* OF = (const bf16*)(F.ws + (br ? WS_OBF : WS_OAF)); const bf16* OB = (const bf16*)(F.ws + (br ? WS_OBB : WS_OAB));
            const bf16* G = (const bf16*)(F.ws + (br ? WS_BG : WS_AG)); bf16* Y = (bf16*)(F.ws + (br ? WS_YB : WS_YA)); const float* on = br ? F.gdn_onorm : F.gla_onorm;
            const size_t off = (size_t)row * 512 + 8 * F.lane; float a[8], bb[8], g[8];
            unpack8(*(const v4u*)(OF + off), a); unpack8(*(const v4u*)(OB + off), bb); unpack8(*(const v4u*)(G + off), g);
            float ss = 0.f;
#pragma unroll
            for (int e = 0; e < 8; ++e) { a[e] += bb[e]; ss += a[e] * a[e]; }
            ss = grp16_sum(ss); const float rs = 1.f / sqrtf(ss * (1.f / 128.f) + EPSV);
            const f32x4* onv = (const f32x4*)(on + ((8 * F.lane) & 127)); const f32x4 o0 = onv[0], o1 = onv[1];
#pragma unroll
            for (int e = 0; e < 4; ++e) { a[e] = a[e] * rs * o0[e] * g[e]; a[4 + e] = a[4 + e] * rs * o1[e] * g[4 + e]; }
            *(v4u*)(Y + off) = pack8(a);
        }
    }
}
__device__ __forceinline__ void p8_final(Frame& F) {
    const float* ROWSS = (const float*)(F.ws + WS_ROWSS);
    for (int row = F.gw; row < NTOK; row += F.NGW) {
        const float rs = 1.f / sqrtf(ROWSS[row] * (1.f / DM) + EPSV);
        f32x4* y = (f32x4*)(F.out + (size_t)row * DM) + F.lane; const f32x4* g = (const f32x4*)F.final_g + F.lane;
#pragma unroll
        for (int j = 0; j < 4; ++j) y[64 * j] = y[64 * j] * rs * g[64 * j];
    }
}

__global__ void __launch_bounds__(NWAVES * 64, 2) mk_fwd(Args args) {
    extern __shared__ __attribute__((aligned(16))) unsigned char lds[];
    Frame F;
    F.lds = (LAS unsigned char*)lds; F.MISC = (volatile LAS unsigned*)(F.lds + MISC_OFF);
    F.tid = threadIdx.x; F.lane = F.tid & 63; F.wave = __builtin_amdgcn_readfirstlane(F.tid >> 6);
    F.G = gridDim.x; { const int bx = blockIdx.x; F.vcu = (F.G % 8 == 0) ? (bx % 8) * (F.G / 8) + bx / 8 : bx; }
    F.gw = F.vcu * NWAVES + F.wave; F.NGW = F.G * NWAVES;
    F.ws = args.ws; F.out = args.out; F.ctl = (unsigned*)(args.ws + WS_CTL);
    F.x = args.in[0]; F.c = args.in[1]; F.ctx = args.in[2]; F.c_ctx = args.in[3]; F.w_mod = args.in[4]; F.b_mod = args.in[5]; F.norm_g = args.in[6]; F.w_in = args.in[7];
    F.gla_up = args.in[8]; F.gla_ub = args.in[9]; F.gla_onorm = args.in[10]; F.gdn_conv = args.in[11]; F.gdn_a_log = args.in[12]; F.gdn_dt_bias = args.in[13]; F.gdn_onorm = args.in[14];
    F.w_gla_out = args.in[15]; F.w_gdn_out = args.in[16]; F.b_gate = args.in[17]; F.w_o = args.in[18]; F.final_g = args.in[19];
    for (int u = F.tid; u < (LDS_BYTES - 131072) / 4; u += NWAVES * 64) ((LAS unsigned*)(F.lds + 131072))[u] = 0u;
    __syncthreads();
    XcdBarrier bar = xcd_barrier_post(F.ctl + CW_BAR, F.MISC + 8);
#define GRID_BAR() xcd_barrier(bar)
    unsigned char* ws = args.ws;
    bf16* H = (bf16*)(ws + WS_H);
#ifndef SKIP_P0
    p0_prologue(F); GRID_BAR();
#endif
#ifndef SKIP_P1
    p1_rows(F); GRID_BAR();
#endif
#ifndef SKIP_P2
    {   pg8::Gemm g{H, (const bf16*)(ws + WS_WTIN), NROWS, NIN, DM}; pg8::StaticOrder S; S.init(NROWS, NIN, F.G, (int)blockIdx.x);
        pg8::EpiIn E{ws, (bf16*)args.out, (float*)(ws + WS_SM), F.b_gate};
        pg8::gemm_phase<pg8::EpiIn, pg8::StaticOrder, PG8_ALIGN, PG8_SP2>(F.lds, g, S, E); }
    GRID_BAR();
#endif
#ifndef SKIP_P3
    p3_conv(F); GRID_BAR();
#endif
#ifndef SKIP_P4
    p4_scan_naive(F); GRID_BAR();
#endif
#ifndef SKIP_P5
    p5_y(F); GRID_BAR();
#endif
#ifndef SKIP_P6
    {   pg8::Gemm g{(const bf16*)(ws + WS_YA), (const bf16*)(ws + WS_WTGA), NTOK, DM, 512}; pg8::StaticOrder S; S.init(NTOK, DM, F.G, (int)blockIdx.x);
        pg8::EpiGa E{(const bf16*)args.out, (float*)(ws + WS_TMP)};
        pg8::gemm_phase<pg8::EpiGa, pg8::StaticOrder, PG8_ALIGN, PG8_SP2>(F.lds, g, S, E); }
    GRID_BAR();
    {   pg8::Gemm g{(const bf16*)(ws + WS_YB), (const bf16*)(ws + WS_WTGD), NTOK, DM, 512}; pg8::StaticOrder S; S.init(NTOK, DM, F.G, (int)blockIdx.x);
        pg8::EpiGb E{(const bf16*)args.out, (const float*)(ws + WS_TMP), (bf16*)(ws + WS_MERGED)};
        pg8::gemm_phase<pg8::EpiGb, pg8::StaticOrder, PG8_ALIGN, PG8_SP2>(F.lds, g, S, E); }
    GRID_BAR();
#endif
#ifndef SKIP_P7
    {   pg8::Gemm g{(const bf16*)(ws + WS_MERGED), (const bf16*)(ws + WS_WTO), NTOK, DM, DM}; pg8::StaticOrder S; S.init(NTOK, DM, F.G, (int)blockIdx.x);
        pg8::EpiOut E{F.x, (const float*)(ws + WS_MOD), args.out, (float*)(ws + WS_ROWSS)};
        pg8::gemm_phase<pg8::EpiOut, pg8::StaticOrder, PG8_ALIGN, PG8_SP2>(F.lds, g, S, E); }
    GRID_BAR();
#endif
#ifndef SKIP_P8
    p8_final(F);
#endif
}

extern "C" void kernel_launch(void* const* d_in, const int* in_sizes, int n_in, void* d_out, int out_size, void* d_ws, size_t ws_size, hipStream_t stream) {
    static int grid = 0;
    if (grid == 0) {
        if (n_in != 20 || out_size != NTOK * DM || ws_size < WS_END) { fprintf(stderr, "kernel_launch: unexpected shapes (n_in %d, out %d, ws %zu); nothing launched\n", n_in, out_size, ws_size); grid = -1; return; }
        int dev = 0, cus = 0;
        if (hipGetDevice(&dev) != hipSuccess || hipDeviceGetAttribute(&cus, hipDeviceAttributeMultiprocessorCount, dev) != hipSuccess) { grid = -1; return; }
        if (hipFuncSetAttribute((const void*)mk_fwd, hipFuncAttributeMaxDynamicSharedMemorySize, LDS_BYTES) != hipSuccess) { fprintf(stderr, "kernel_launch: hipFuncSetAttribute failed\n"); grid = -1; return; }
        (void)hipGetLastError();
        grid = cus;
    }
    if (grid < 0) return;
    if (hipMemsetAsync((char*)d_ws + WS_CTL, 0, CTL_ZERO_BYTES, stream) != hipSuccess) { fprintf(stderr, "kernel_launch: memset failed\n"); return; }
    Args a{};
    for (int i = 0; i < 20; ++i) a.in[i] = (const float*)d_in[i];
    a.out = (float*)d_out; a.ws = (unsigned char*)d_ws;
    hipLaunchKernelGGL(mk_fwd, dim3(grid), dim3(NWAVES * 64), LDS_BYTES, stream, a);
}
```

```cpp
#include <hip/hip_runtime.h>
#include <cstdio>
#include <cstdint>
namespace pg8 {
#define PG8_LAS __attribute__((address_space(3)))
typedef unsigned short bf16_t;
typedef short bf16x8 __attribute__((ext_vector_type(8)));
typedef float f32x4 __attribute__((ext_vector_type(4)));
typedef unsigned u32x4 __attribute__((ext_vector_type(4)));
constexpr int BM = 256, BK = 64, HALF = 128, HTB = HALF * BK * 2  , STAGE_BYTES = 8 * HTB, NXCD = 8, WGM = 8;

__host__ __device__ __forceinline__ int lds_byte(int r, int c) { const int st = (r >> 4) * 2 + (c >> 5), rr = r & 15, cc = c & 31, ob = rr * 64 + cc * 2; return st * 1024 + (ob ^ (((ob >> 9) & 1) << 5)); }
__host__ __device__ __forceinline__ void stage_rc(int b, int& R, int& C) { const int st = b / 1024, sb = b % 1024, swz = sb ^ (((sb >> 9) & 1) << 5); R = (st >> 1) * 16 + swz / 64; C = (st & 1) * 32 + (swz % 64) / 2; }
__host__ __device__ __forceinline__ int perm32(int rho) { const int n = rho >> 4, i = rho & 15; return 8 * (i >> 2) + 4 * n + (i & 3); }

struct Unit { int pm, pn; };
struct Gemm { const bf16_t* A; const bf16_t* Bt; int M, N, K; };

struct StaticOrder {
    int nM, nN, nwg, G, c;
    __host__ __device__ void init(int M, int N, int G_, int c_) { nM = M / BM; nN = N / BM; nwg = nM * nN; G = G_; c = c_; }
    __host__ __device__ bool next(int i, Unit& u) const {
        const long L = (long)i * G + c; if (L >= nwg) return false;
        int wgid = (int)L; { const int q = nwg / NXCD, r = nwg % NXCD, xcd = wgid % NXCD, off = wgid / NXCD; wgid = (xcd < r ? xcd * (q + 1) : r * (q + 1) + (xcd - r) * q) + off; }
        const int nig = WGM * nN, gid = wgid / nig, fm = gid * WGM, gsz = (nM - fm) < WGM ? (nM - fm) : WGM;
        u.pm = fm + ((wgid % nig) % gsz); u.pn = (wgid % nig) / gsz; return true;
    }
    __device__ __forceinline__ void a_ready(const Unit&) const {}
    __device__ __forceinline__ void done(const Unit&) const {}
};

__device__ __forceinline__ unsigned cvt_pk_bf16(float lo, float hi) { unsigned r; asm volatile("v_cvt_pk_bf16_f32 %0, %1, %2" : "=v"(r) : "v"(lo), "v"(hi)); return r; }
typedef float f32x2 __attribute__((ext_vector_type(2)));
__device__ __forceinline__ f32x2 gelu_pk(f32x2 v) {
    const f32x2 av = __builtin_elementwise_abs(v), d = av * 0.2316418882f + 1.0f;
    f32x2 t; t.x = __builtin_amdgcn_rcpf(d.x); t.y = __builtin_amdgcn_rcpf(d.y);
    f32x2 q = t * 0.5307027145f + (-0.7265760135f); q = q * t + 0.7107068705f; q = q * t + (-0.142248368f); q = q * t + 0.127414796f; q = q * t;
    const f32x2 s = (v * v) * (-0.72134752044f);
    f32x2 e; e.x = __builtin_amdgcn_exp2f(s.x); e.y = __builtin_amdgcn_exp2f(s.y);
    const f32x2 m = v * (q * e), r = v - m;
    f32x2 o; o.x = v.x < 0.f ? m.x : r.x; o.y = v.y < 0.f ? m.y : r.y; return o;
}

template <int ACT  > struct EpiBf16 {
    static constexpr bool PERM = true, AFTER_DRAIN = false; static_assert(ACT == 0 || ACT == 1, "EpiBf16: ACT is 0 (none) or 1 (gelu_pk)");
    bf16_t* O; int ldc; const float* bias; int split_cols; size_t split_stride; float scale0;
    __device__ __forceinline__ void operator()(const f32x4 (&acc)[2][2][4][2], const Unit& u, int wr, int wc, int fr, int fq) const {
        const int row0 = u.pm * BM + wr * 64 + fr; int colt = u.pn * BM; bf16_t* base = O;
        float sc = 1.f; if (split_cols) { const int t = colt / split_cols; base += (size_t)t * split_stride; colt -= t * split_cols; if (t == 0) sc = scale0; }
        const int col0 = colt + wc * 32 + 8 * fq, bcol0 = u.pn * BM + wc * 32 + 8 * fq;
        f32x4 bv[2][2];
#pragma unroll
        for (int bj = 0; bj < 2; ++bj)
#pragma unroll
            for (int n = 0; n < 2; ++n) bv[bj][n] = bias ? *(const f32x4*)(bias + bcol0 + bj * HALF + 4 * n) : (f32x4){0.f, 0.f, 0.f, 0.f};
#pragma unroll
        for (int ai = 0; ai < 2; ++ai)
#pragma unroll
            for (int m = 0; m < 4; ++m) { bf16_t* rowp = base + (size_t)(row0 + ai * HALF + m * 16) * ldc + col0;
#pragma unroll
                for (int bj = 0; bj < 2; ++bj) { f32x4 v0 = acc[ai][bj][m][0] + bv[bj][0], v1 = acc[ai][bj][m][1] + bv[bj][1];
                    if (ACT == 1) { f32x2 a = gelu_pk((f32x2){v0[0], v0[1]}), b = gelu_pk((f32x2){v0[2], v0[3]}), c = gelu_pk((f32x2){v1[0], v1[1]}), d = gelu_pk((f32x2){v1[2], v1[3]});
                        v0 = (f32x4){a.x, a.y, b.x, b.y}; v1 = (f32x4){c.x, c.y, d.x, d.y}; }
                    v0 = v0 * sc; v1 = v1 * sc; u32x4 w; w.x = cvt_pk_bf16(v0[0], v0[1]); w.y = cvt_pk_bf16(v0[2], v0[3]); w.z = cvt_pk_bf16(v1[0], v1[1]); w.w = cvt_pk_bf16(v1[2], v1[3]);
                    *(u32x4*)(rowp + bj * HALF) = w; } }
    }
};

template <class Epi, class Sched, bool ALIGN_EPI = false, bool SP2 = false>
__device__ __forceinline__ void gemm_phase(PG8_LAS unsigned char* lds, const Gemm g, const Sched& S, const Epi& E) {
    const int tid = threadIdx.x, wid = __builtin_amdgcn_readfirstlane(tid >> 6), lane = tid & 63, wr = wid >> 2, wc = wid & 3, fr = lane & 15, fq = lane >> 4;
    const int K = g.K, nt = K / BK;
    unsigned voffA[2], voffB[2];
#pragma unroll
    for (int i = 0; i < 2; ++i) { int R, C; stage_rc(tid * 16 + i * 8192, R, C); const int Rb = Epi::PERM ? ((R & ~31) + perm32(R & 31)) : R;
        voffA[i] = (unsigned)(R * K + C) * 2u; voffB[i] = (unsigned)(Rb * K + C) * 2u; }
    const size_t kstep = (size_t)(BK * 2);
    const size_t hstep = (size_t)HALF * K * 2;
    const size_t tstep = 2 * hstep;
    const unsigned ldsw = (unsigned)wid * 1024u;
    const int aoff = lds_byte(wr * 64 + fr, fq * 8), boff = lds_byte(wc * 32 + fr, fq * 8);
#define PG8_SA(b, h) (((b) * 2 + (h)) * HTB)
#define PG8_SB(b, h) ((4 + (b) * 2 + (h)) * HTB)
#define PG8_STAGE(bufoff, gbase, voff) do { _Pragma("unroll") for (int _i = 0; _i < 2; ++_i) \
        __builtin_amdgcn_global_load_lds((const unsigned*)((const char*)(gbase) + (voff)[_i]), (PG8_LAS unsigned*)(lds + (bufoff) + ldsw + _i * 8192), 16, 0, 0); } while (0)
#define PG8_LDA(dst, b, h) do { _Pragma("unroll") for (int m = 0; m < 4; ++m) _Pragma("unroll") for (int k = 0; k < 2; ++k) dst[m][k] = *(const PG8_LAS bf16x8*)(lds + PG8_SA(b, h) + aoff + m * 2048 + k * 1024); } while (0)
#define PG8_LDB(dst, b, h) do { _Pragma("unroll") for (int n = 0; n < 2; ++n) _Pragma("unroll") for (int k = 0; k < 2; ++k) dst[n][k] = *(const PG8_LAS bf16x8*)(lds + PG8_SB(b, h) + boff + n * 2048 + k * 1024); } while (0)
#define PG8_MMA(ai, bj, At, Bt) do { __builtin_amdgcn_s_setprio(1); _Pragma("unroll") for (int m = 0; m < 4; ++m) _Pragma("unroll") for (int n = 0; n < 2; ++n) _Pragma("unroll") for (int k = 0; k < 2; ++k) \
        acc[ai][bj][m][n] = __builtin_amdgcn_mfma_f32_16x16x32_bf16(Bt[n][k], At[m][k], acc[ai][bj][m][n], 0, 0, 0); __builtin_amdgcn_s_setprio(0); } while (0)
#define PG8_WAIT_V(n) asm volatile("s_waitcnt vmcnt(" #n ")" ::: "memory")
#define PG8_WAIT_L(n) asm volatile("s_waitcnt lgkmcnt(" #n ")" ::: "memory")
#define PG8_BAR __builtin_amdgcn_s_barrier()
#define PG8_SCHED __builtin_amdgcn_sched_barrier(0)
    Unit cur, nxt; int ui = 0;
    if (!S.next(0, cur)) return;
    f32x4 acc[2][2][4][2];
#pragma unroll
    for (int a = 0; a < 2; ++a)
#pragma unroll
        for (int b = 0; b < 2; ++b)
#pragma unroll
            for (int m = 0; m < 4; ++m)
#pragma unroll
                for (int n = 0; n < 2; ++n) acc[a][b][m][n] = (f32x4){0.f, 0.f, 0.f, 0.f};
    bf16x8 At[4][2], B0[2][2], B1[2][2];
    const char* cA = (const char*)g.A + (size_t)cur.pm * tstep; const char* cB = (const char*)g.Bt + (size_t)cur.pn * tstep;
    S.a_ready(cur);
    if constexpr (SP2) {
        PG8_STAGE(PG8_SB(0, 0), cB, voffB); PG8_STAGE(PG8_SB(0, 1), cB + hstep, voffB); PG8_STAGE(PG8_SA(0, 0), cA, voffA); PG8_STAGE(PG8_SA(0, 1), cA + hstep, voffA);
        if (wr == 1) PG8_BAR;
        PG8_WAIT_V(2); PG8_BAR;
        PG8_STAGE(PG8_SB(1, 0), cB + kstep, voffB); PG8_STAGE(PG8_SA(1, 0), cA + kstep, voffA); PG8_STAGE(PG8_SB(1, 1), cB + hstep + kstep, voffB);
        PG8_WAIT_V(6); PG8_BAR;
    } else {
        PG8_STAGE(PG8_SB(0, 0), cB, voffB); PG8_STAGE(PG8_SA(0, 0), cA, voffA); PG8_STAGE(PG8_SB(0, 1), cB + hstep, voffB); PG8_STAGE(PG8_SA(0, 1), cA + hstep, voffA);
        if (wr == 1) PG8_BAR;
        PG8_WAIT_V(4); PG8_BAR;
        PG8_STAGE(PG8_SB(1, 0), cB + kstep, voffB); PG8_STAGE(PG8_SA(1, 0), cA + kstep, voffA); PG8_STAGE(PG8_SB(1, 1), cB + hstep + kstep, voffB);
        PG8_WAIT_V(6); PG8_BAR;
    }
    for (;;) {
        const bool has_next = S.next(ui + 1, nxt);
        const char* nA = has_next ? (const char*)g.A + (size_t)nxt.pm * tstep : cA; const char* nB = has_next ? (const char*)g.Bt + (size_t)nxt.pn * tstep : cB;
        for (int t = 0; t < nt; t += 2) {
            const bool last = (t == nt - 2);
            const char* a1 = cA + (size_t)(t + 1) * kstep;
            const char* a2 = last ? nA : cA + (size_t)(t + 2) * kstep; const char* b2 = last ? nB : cB + (size_t)(t + 2) * kstep;
            const char* a3 = a2 + kstep; const char* b3 = b2 + kstep;
            if (last && has_next) S.a_ready(nxt);
            if constexpr (SP2) {
            PG8_LDB(B0, 0, 0); PG8_LDB(B1, 0, 1); PG8_SCHED; PG8_LDA(At, 0, 0); PG8_STAGE(PG8_SA(1, 1), a1 + hstep, voffA);
            PG8_WAIT_V(8); PG8_WAIT_L(0); PG8_BAR; PG8_MMA(0, 0, At, B0); PG8_MMA(0, 1, At, B1); PG8_BAR; PG8_SCHED;
            PG8_LDA(At, 0, 1); PG8_STAGE(PG8_SB(0, 0), b2, voffB); PG8_STAGE(PG8_SB(0, 1), b2 + hstep, voffB); PG8_STAGE(PG8_SA(0, 0), a2, voffA);
            PG8_WAIT_V(8); PG8_WAIT_L(0); PG8_BAR; PG8_MMA(1, 0, At, B0); PG8_MMA(1, 1, At, B1); PG8_BAR; PG8_SCHED;
            PG8_LDB(B0, 1, 0); PG8_LDB(B1, 1, 1); PG8_SCHED; PG8_LDA(At, 1, 0); PG8_STAGE(PG8_SA(0, 1), a2 + hstep, voffA);
            PG8_WAIT_V(8); PG8_WAIT_L(0); PG8_BAR; PG8_MMA(0, 0, At, B0); PG8_MMA(0, 1, At, B1); PG8_BAR; PG8_SCHED;
            PG8_LDA(At, 1, 1); PG8_STAGE(PG8_SB(1, 0), b3, voffB); PG8_STAGE(PG8_SB(1, 1), b3 + hstep, voffB); PG8_STAGE(PG8_SA(1, 0), a3, voffA);
            PG8_WAIT_V(8); PG8_WAIT_L(0); PG8_BAR; PG8_MMA(1, 0, At, B0); PG8_MMA(1, 1, At, B1); PG8_BAR; PG8_SCHED;
            } else {
            PG8_LDB(B0, 0, 0); PG8_SCHED; PG8_LDA(At, 0, 0); PG8_STAGE(PG8_SA(1, 1), a1 + hstep, voffA);
            PG8_WAIT_L(8); PG8_BAR; PG8_WAIT_L(0); PG8_MMA(0, 0, At, B0); PG8_BAR; PG8_SCHED;
            PG8_LDB(B1, 0, 1); PG8_STAGE(PG8_SB(0, 0), b2, voffB);
            PG8_BAR; PG8_WAIT_L(0); PG8_MMA(0, 1, At, B1); PG8_BAR;
            PG8_LDA(At, 0, 1); PG8_STAGE(PG8_SA(0, 0), a2, voffA);
            PG8_BAR; PG8_WAIT_L(0); PG8_MMA(1, 0, At, B0); PG8_BAR; PG8_SCHED;
            PG8_STAGE(PG8_SB(0, 1), b2 + hstep, voffB);
            PG8_WAIT_V(6); PG8_BAR; PG8_MMA(1, 1, At, B1); PG8_BAR;
            PG8_LDB(B0, 1, 0); PG8_SCHED; PG8_LDA(At, 1, 0); PG8_STAGE(PG8_SA(0, 1), a2 + hstep, voffA);
            PG8_WAIT_L(8); PG8_BAR; PG8_WAIT_L(0); PG8_MMA(0, 0, At, B0); PG8_BAR; PG8_SCHED;
            PG8_LDB(B1, 1, 1); PG8_STAGE(PG8_SB(1, 0), b3, voffB);
            PG8_BAR; PG8_WAIT_L(0); PG8_MMA(0, 1, At, B1); PG8_BAR;
            PG8_LDA(At, 1, 1); PG8_STAGE(PG8_SA(1, 0), a3, voffA);
            PG8_BAR; PG8_WAIT_L(0); PG8_MMA(1, 0, At, B0); PG8_BAR; PG8_SCHED;
            PG8_STAGE(PG8_SB(1, 1), b3 + hstep, voffB);
            PG8_WAIT_V(6); PG8_BAR; PG8_MMA(1, 1, At, B1); PG8_BAR;
            }
        }
        if constexpr (ALIGN_EPI) { if (wr == 0) PG8_BAR; }
        if constexpr (!Epi::AFTER_DRAIN) { E(acc, cur, wr, wc, fr, fq); S.done(cur); }
        if (!has_next) break;
#pragma unroll
        for (int a = 0; a < 2; ++a)
#pragma unroll
            for (int b = 0; b < 2; ++b)
#pragma unroll
                for (int m = 0; m < 4; ++m)
#pragma unroll
                    for (int n = 0; n < 2; ++n) acc[a][b][m][n] = (f32x4){0.f, 0.f, 0.f, 0.f};
        cur = nxt; cA = nA; cB = nB; ++ui;
        if constexpr (ALIGN_EPI) { if (wr == 1) PG8_BAR; }
    }
    PG8_WAIT_V(0);
    if constexpr (!ALIGN_EPI) { if (wr == 0) PG8_BAR; }
    PG8_BAR;
    if constexpr (Epi::AFTER_DRAIN) { E.fused(acc, cur, wr, wc, fr, fq, lds, wid, lane); S.done(cur); }
#undef PG8_SA
#undef PG8_SB
#undef PG8_STAGE
#undef PG8_LDA
#undef PG8_LDB
#undef PG8_MMA
#undef PG8_WAIT_V
#undef PG8_WAIT_L
#undef PG8_BAR
#undef PG8_SCHED
}
}
#define PG8_SP2 true
#define PG8_ALIGN true
constexpr int NWAVES = 8;
constexpr int BATCH = 8, SEQ = 2048, DM = 1024, CTXL = 256, NTOK = BATCH * SEQ, NCTX = BATCH * CTXL, NROWS = NTOK + NCTX;
constexpr int C_ALR = 1536, C_BQ = 1568, C_BG = 3104, C_BBETA = 3616, C_MG = 3632, D_IN = 5680;
constexpr int NIN = 5888;
constexpr int NSM = 48;
constexpr float EPSV = 1e-6f;
constexpr size_t MiB = 1u << 20;
constexpr size_t WS_CTL = 0, CTL_ZERO_BYTES = 1 * MiB;
constexpr int CW_BAR = 4096;
constexpr size_t WS_MOD = 64 * 1024, WS_ROWSS = 256 * 1024;
constexpr size_t WS_WTIN = 2 * MiB, WS_WTGA = 14 * MiB, WS_WTGD = 15 * MiB, WS_WTO = 16 * MiB;
constexpr size_t WS_H = 18 * MiB, WS_AQ = 54 * MiB, WS_AK = 62 * MiB, WS_PRE = 71 * MiB, WS_SM = 125 * MiB, WS_VTA = 129 * MiB;
constexpr size_t WS_KIMG = 147 * MiB, WS_KTIMG = 165 * MiB, WS_VT = 183 * MiB, WS_TBIMG = 201 * MiB, WS_KDTIMG = 219 * MiB, WS_SCAL = 237 * MiB, WS_EBL = 239 * MiB;
constexpr size_t DO_QIMG = 0, DO_AQKIMG = 16 * MiB, DO_QEIMG = 32 * MiB, DO_ATTIMG = 48 * MiB;
#ifndef DBG_NAIVE_GDN
#define DBG_NAIVE_GDN 0
#endif
#ifndef DBG_NAIVE_GLA
#define DBG_NAIVE_GLA 0
#endif
#if DBG_NAIVE_GLA
constexpr size_t WS_OAF = 219 * MiB, WS_OAB = 240 * MiB;
#else
constexpr size_t WS_OAF = 54 * MiB, WS_OAB = 70 * MiB;
#endif
constexpr size_t WS_OBF = 86 * MiB, WS_OBB = 102 * MiB, WS_AG = 118 * MiB, WS_BG = 134 * MiB, WS_YA = 150 * MiB, WS_YB = 166 * MiB;
constexpr size_t WS_TMP = 182 * MiB, WS_MERGED = 18 * MiB, WS_END = 256 * MiB;
constexpr size_t WS_POST = WS_KIMG, DO_DBGAV = 32 * MiB;
constexpr int LDS_BYTES = 147456 + 256;
constexpr int MISC_OFF = 147456;

#define GAS __attribute__((address_space(1)))
#define LAS __attribute__((address_space(3)))
typedef unsigned short bf16;
typedef unsigned v4u __attribute__((ext_vector_type(4)));
typedef unsigned v2u __attribute__((ext_vector_type(2)));
typedef float f32x4 __attribute__((ext_vector_type(4)));
#define LDS_WAIT() asm volatile("s_waitcnt lgkmcnt(0)" ::: "memory")
#define VM_WAIT() asm volatile("s_waitcnt vmcnt(0)" ::: "memory")
__device__ __forceinline__ unsigned f2bf(float f) { unsigned u = __builtin_bit_cast(unsigned, f); return (u + 0x7fffu + ((u >> 16) & 1u)) >> 16; }
__device__ __forceinline__ unsigned pk2(float lo, float hi) { return f2bf(lo) | (f2bf(hi) << 16); }
__device__ __forceinline__ float bflo(unsigned w) { return __builtin_bit_cast(float, w << 16); }
__device__ __forceinline__ float bfhi(unsigned w) { return __builtin_bit_cast(float, w & 0xffff0000u); }
__device__ __forceinline__ float bf2f(bf16 b) { return __builtin_bit_cast(float, ((unsigned)b) << 16); }
__device__ __forceinline__ float fsigm(float x) { return __builtin_amdgcn_rcpf(1.f + __expf(-x)); }
__device__ __forceinline__ float fsilu(float x) { return x * fsigm(x); }
__device__ __forceinline__ float softplusf_(float x) { return fmaxf(x, 0.f) + log1pf(expf(-fabsf(x))); }
__device__ __forceinline__ float logsigf_(float x) { return fminf(x, 0.f) - log1pf(expf(-fabsf(x))); }
__device__ __forceinline__ void unpack8(v4u w, float (&v)[8]) { v[0] = bflo(w.x); v[1] = bfhi(w.x); v[2] = bflo(w.y); v[3] = bfhi(w.y); v[4] = bflo(w.z); v[5] = bfhi(w.z); v[6] = bflo(w.w); v[7] = bfhi(w.w); }
__device__ __forceinline__ v4u pack8(const float (&v)[8]) { v4u w; w.x = pk2(v[0], v[1]); w.y = pk2(v[2], v[3]); w.z = pk2(v[4], v[5]); w.w = pk2(v[6], v[7]); return w; }
__device__ __forceinline__ float wave_sum(float v) {
#pragma unroll
    for (int o = 1; o < 64; o <<= 1) v += __shfl_xor(v, o);
    return v;
}
__device__ __forceinline__ float grp16_sum(float v) {
#pragma unroll
    for (int o = 1; o < 16; o <<= 1) v += __shfl_xor(v, o);
    return v;
}

#define XB_TMO      128
#define XB_XCNT(j)  (256  + 64 * (j))
#define XB_XSUB(j)  (1280 + 64 * (j))
#define XB_XGEN(j)  (2304 + 64 * (j))
#define XB_TOP      3328
#define XB_TOPGEN   3392
#define XCD_BAR_WORDS 3456
#define XB_SPIN_CAP (1u << 22)
__device__ __forceinline__ unsigned xb_ld(unsigned* p)              { return __hip_atomic_load(p, __ATOMIC_RELAXED, __HIP_MEMORY_SCOPE_AGENT); }
__device__ __forceinline__ unsigned xb_add(unsigned* p, unsigned v) { return __hip_atomic_fetch_add(p, v, __ATOMIC_RELAXED, __HIP_MEMORY_SCOPE_AGENT); }
__device__ __forceinline__ unsigned xb_xcc_id() { return (unsigned)__builtin_amdgcn_s_getreg((3 << 11) | 20) & 0xFu; }
#define XB_SPIN(cond, bar) do { unsigned _sp = 0; while (cond) { __builtin_amdgcn_s_sleep(1); \
    if ((++_sp & 255u) == 0u) { if (xb_ld(&(bar)[XB_TMO])) break; if (_sp > XB_SPIN_CAP) { atomicAdd(&(bar)[XB_TMO], 1u); break; } } } } while (0)
struct XcdBarrier { unsigned* bar; unsigned x; volatile LAS unsigned* st; };
__device__ __forceinline__ XcdBarrier xcd_barrier_post(unsigned* bar, volatile LAS unsigned* st) {
    XcdBarrier b; b.bar = bar; b.x = xb_xcc_id(); b.st = st;
    if (threadIdx.x == 0) (void)xb_add(&bar[XB_XCNT(b.x)], 1u);
    return b;
}
__device__ __forceinline__ void xcd_barrier_complete(unsigned* bar, unsigned x, unsigned& nloc, unsigned& nx) {
    const unsigned G = gridDim.x * gridDim.y * gridDim.z;
    unsigned sum, cnt, mine, sp = 0u;
    for (;;) {
        sum = 0u; cnt = 0u; mine = 0u;
#pragma unroll
        for (unsigned j = 0; j < 16; ++j) { const unsigned c = xb_ld(&bar[XB_XCNT(j)]); sum += c; cnt += (c > 0u) ? 1u : 0u; mine = (j == x) ? c : mine; }
        if (sum == G) break;
        __builtin_amdgcn_s_sleep(1);
        if ((++sp & 255u) == 0u) { if (xb_ld(&bar[XB_TMO])) break; if (sp > XB_SPIN_CAP) { atomicAdd(&bar[XB_TMO], 1u); break; } }
    }
    nloc = mine > 0u ? mine : 1u; nx = cnt > 0u ? cnt : 1u;
}
__device__ __forceinline__ void xcd_barrier(const XcdBarrier& b) {
    asm volatile("s_waitcnt vmcnt(0)" ::: "memory");
    __syncthreads();
    if (threadIdx.x == 0) {
        unsigned* bar = b.bar;
        __builtin_amdgcn_s_waitcnt(0);
        unsigned nloc = b.st[0], nx = b.st[1];
        if (nloc == 0u) { xcd_barrier_complete(bar, b.x, nloc, nx); b.st[0] = nloc; b.st[1] = nx; }
        const unsigned old = xb_add(&bar[XB_XSUB(b.x)], 1u);
        const unsigned gen = old / nloc;
        if (old + 1u == (gen + 1u) * nloc) {
            __builtin_amdgcn_fence(__ATOMIC_RELEASE, "agent");
            asm volatile("s_waitcnt vmcnt(0)" ::: "memory");
            const unsigned og = xb_add(&bar[XB_TOP], 1u);
            const unsigned tg = og / nx;
            if (og + 1u == (tg + 1u) * nx) xb_add(&bar[XB_TOPGEN], 1u);
            else XB_SPIN(xb_ld(&bar[XB_TOPGEN]) == tg, bar);
            __builtin_amdgcn_fence(__ATOMIC_ACQUIRE, "agent");
            xb_add(&bar[XB_XGEN(b.x)], 1u);
            asm volatile("s_waitcnt vmcnt(0)" ::: "memory");
        } else {
            XB_SPIN(xb_ld(&bar[XB_XGEN(b.x)]) == gen, bar);
            __builtin_amdgcn_fence(__ATOMIC_ACQUIRE, "agent");
            asm volatile("s_waitcnt vmcnt(0)" ::: "memory");
        }
    }
    __syncthreads();
}

namespace pg8 {
struct EpiIn {
    static constexpr bool PERM = true, AFTER_DRAIN = false;
    unsigned char* ws; bf16* GATES; float* SM; const float* b_gate; int pnoff;
    __device__ __forceinline__ void operator()(const f32x4 (&acc)[2][2][4][2], const Unit& u, int wr, int wc, int fr, int fq) const {
        const int pn = u.pn + pnoff, row0 = u.pm * BM + wr * 64 + fr; const bool lat = u.pm < NTOK / BM;
        if (pn == 10) {
            if (wc > 1 || (wc == 1 && fq >= 2)) return;
            const int c0 = wc * 32 + 8 * fq;
#pragma unroll
            for (int ai = 0; ai < 2; ++ai)
#pragma unroll
                for (int m = 0; m < 4; ++m) { float* rp = SM + (size_t)(row0 + ai * HALF + m * 16) * NSM + c0;
                    *(f32x4*)rp = acc[ai][0][m][0]; *(f32x4*)(rp + 4) = acc[ai][0][m][1]; }
            return;
        }
        if (pn == 2 || pn == 3) {
            bf16* VTA = (bf16*)(ws + WS_VTA);
#if DBG_NAIVE_GLA
            bf16* AVR = GATES + DO_DBGAV / 2;
#endif
#pragma unroll
            for (int ai = 0; ai < 2; ++ai)
#pragma unroll
                for (int m = 0; m < 4; ++m) { const int row = row0 + ai * HALF + m * 16; int b, cid;
                    if (row < NTOK) { b = row >> 11; cid = 4 + ((row & 2047) >> 6); } else { const int rr = row - NTOK; b = rr >> 8; cid = (rr & 255) >> 6; }
                    const int pos = row & 63;
#pragma unroll
                    for (int bj = 0; bj < 2; ++bj) { const int h = (pn - 2) * 2 + bj; bf16* dst = VTA + ((size_t)((b * 4 + h) * 36 + cid) * 128 + wc * 32 + 8 * fq) * 64 + pos;
#pragma unroll
                        for (int n = 0; n < 2; ++n)
#pragma unroll
                            for (int j = 0; j < 4; ++j) dst[(4 * n + j) * 64] = (bf16)(cvt_pk_bf16(acc[ai][bj][m][n][j], 0.f) & 0xffffu);
#if DBG_NAIVE_GLA
                        u32x4 w; w.x = cvt_pk_bf16(acc[ai][bj][m][0][0], acc[ai][bj][m][0][1]); w.y = cvt_pk_bf16(acc[ai][bj][m][0][2], acc[ai][bj][m][0][3]); w.z = cvt_pk_bf16(acc[ai][bj][m][1][0], acc[ai][bj][m][1][1]); w.w = cvt_pk_bf16(acc[ai][bj][m][1][2], acc[ai][bj][m][1][3]);
                        *(u32x4*)(AVR + (size_t)row * 512 + (pn - 2) * 256 + bj * HALF + wc * 32 + 8 * fq) = w;
#endif
                    } }
            return;
        }
        size_t boff; int ld, cb, act = 0; float sc = 1.f; bool latonly = false;
        if (pn == 0) { boff = WS_AQ; ld = 256; cb = 0; sc = 0.125f; latonly = true; }
        else if (pn == 1) { boff = WS_AK; ld = 256; cb = 0; }
        else if (pn < 10) { boff = WS_PRE; ld = 1536; cb = (pn - 4) * 256; }
        else if (pn < 13) { boff = WS_AG; ld = 512; cb = (pn - 11) * 256; act = 1; latonly = true; }
        else if (pn < 15) { boff = WS_BG; ld = 512; cb = (pn - 13) * 256; act = 1; latonly = true; }
        else { boff = 0; ld = 2048; cb = (pn - 15) * 256; act = 2; latonly = true; }
        bf16* base = (pn >= 15) ? GATES : (bf16*)(ws + boff);
        if (latonly && !lat) return;
        const int col0 = cb + wc * 32 + 8 * fq;
#pragma unroll
        for (int ai = 0; ai < 2; ++ai)
#pragma unroll
            for (int m = 0; m < 4; ++m) { bf16* rowp = base + (size_t)(row0 + ai * HALF + m * 16) * ld + col0;
#pragma unroll
                for (int bj = 0; bj < 2; ++bj) { f32x4 v0 = acc[ai][bj][m][0], v1 = acc[ai][bj][m][1];
                    if (act == 1) {
#pragma unroll
                        for (int j = 0; j < 4; ++j) { v0[j] = fsilu(v0[j]); v1[j] = fsilu(v1[j]); } }
                    else if (act == 2) { const f32x4 b0 = *(const f32x4*)(b_gate + col0 + bj * HALF), b1 = *(const f32x4*)(b_gate + col0 + bj * HALF + 4);
#pragma unroll
                        for (int j = 0; j < 4; ++j) { v0[j] = fsigm(v0[j] + b0[j]); v1[j] = fsigm(v1[j] + b1[j]); } }
                    else { v0 = v0 * sc; v1 = v1 * sc; }
                    u32x4 w; w.x = cvt_pk_bf16(v0[0], v0[1]); w.y = cvt_pk_bf16(v0[2], v0[3]); w.z = cvt_pk_bf16(v1[0], v1[1]); w.w = cvt_pk_bf16(v1[2], v1[3]);
                    *(u32x4*)(rowp + bj * HALF) = w; } }
    }
};
struct OrderA {
    int G, c;
    __device__ void init(int G_, int c_) { G = G_; c = c_; }
    __device__ bool next(int i, Unit& u) const {
        const int L = i * G + c; if (L >= 768) return false;
        if (L < 704) { int wgid = L; { const int q = 704 / NXCD, xcd = wgid % NXCD, off = wgid / NXCD; wgid = xcd * q + off; }
            const int nN = 11, nM = 64, nig = WGM * nN, gid = wgid / nig, fm = gid * WGM, gsz = (nM - fm) < WGM ? (nM - fm) : WGM;
            u.pm = fm + ((wgid % nig) % gsz); u.pn = (wgid % nig) / gsz; return true; }
        const int l2 = L - 704, idx = l2 >> 3; u.pm = 64 + (l2 & 7); u.pn = idx < 3 ? idx + 1 : idx + 3; return true;
    }
    __device__ __forceinline__ void a_ready(const Unit&) const {}
    __device__ __forceinline__ void done(const Unit&) const {}
};
struct EpiGa {
    static constexpr bool PERM = true, AFTER_DRAIN = false;
    const bf16* GATES; float* TMP;
    __device__ __forceinline__ void operator()(const f32x4 (&acc)[2][2][4][2], const Unit& u, int wr, int wc, int fr, int fq) const {
        const int row0 = u.pm * BM + wr * 64 + fr, col0 = u.pn * BM + wc * 32 + 8 * fq;
#pragma unroll
        for (int ai = 0; ai < 2; ++ai)
#pragma unroll
            for (int m = 0; m < 4; ++m) { const size_t r = (size_t)(row0 + ai * HALF + m * 16);
#pragma unroll
                for (int bj = 0; bj < 2; ++bj) { const u32x4 g = *(const u32x4*)(GATES + r * 2048 + col0 + bj * HALF); float gv[8]; unpack8((v4u)g, gv);
                    f32x4 v0 = acc[ai][bj][m][0], v1 = acc[ai][bj][m][1];
#pragma unroll
                    for (int j = 0; j < 4; ++j) { v0[j] *= gv[j]; v1[j] *= gv[4 + j]; }
                    float* tp = TMP + r * 1024 + col0 + bj * HALF; *(f32x4*)tp = v0; *(f32x4*)(tp + 4) = v1; } }
    }
};
struct EpiGb {
    static constexpr bool PERM = true, AFTER_DRAIN = false;
    const bf16* GATES; const float* TMP; bf16* MERGED;
    __device__ __forceinline__ void operator()(const f32x4 (&acc)[2][2][4][2], const Unit& u, int wr, int wc, int fr, int fq) const {
        const int row0 = u.pm * BM + wr * 64 + fr, col0 = u.pn * BM + wc * 32 + 8 * fq;
#pragma unroll
        for (int ai = 0; ai < 2; ++ai)
#pragma unroll
            for (int m = 0; m < 4; ++m) { const size_t r = (size_t)(row0 + ai * HALF + m * 16);
#pragma unroll
                for (int bj = 0; bj < 2; ++bj) { const u32x4 g = *(const u32x4*)(GATES + r * 2048 + 1024 + col0 + bj * HALF); float gv[8]; unpack8((v4u)g, gv);
                    const float* tp = TMP + r * 1024 + col0 + bj * HALF; f32x4 v0 = *(const f32x4*)tp, v1 = *(const f32x4*)(tp + 4);
#pragma unroll
                    for (int j = 0; j < 4; ++j) { v0[j] += gv[j] * acc[ai][bj][m][0][j]; v1[j] += gv[4 + j] * acc[ai][bj][m][1][j]; }
                    u32x4 w; w.x = cvt_pk_bf16(v0[0], v0[1]); w.y = cvt_pk_bf16(v0[2], v0[3]); w.z = cvt_pk_bf16(v1[0], v1[1]); w.w = cvt_pk_bf16(v1[2], v1[3]);
                    *(u32x4*)(MERGED + r * 1024 + col0 + bj * HALF) = w; } }
    }
};
struct EpiOut {
    static constexpr bool PERM = true, AFTER_DRAIN = false;
    const float* x; const float* MOD; float* out; float* ROWSS;
    __device__ __forceinline__ void operator()(const f32x4 (&acc)[2][2][4][2], const Unit& u, int wr, int wc, int fr, int fq) const {
        const int row0 = u.pm * BM + wr * 64 + fr, col0 = u.pn * BM + wc * 32 + 8 * fq;
        const float* gt = MOD + (size_t)(u.pm * BM / SEQ) * 3072 + 2048 + col0;
        f32x4 g[2][2];
#pragma unroll
        for (int bj = 0; bj < 2; ++bj) { g[bj][0] = *(const f32x4*)(gt + bj * HALF); g[bj][1] = *(const f32x4*)(gt + bj * HALF + 4); }
#pragma unroll
        for (int ai = 0; ai < 2; ++ai)
#pragma unroll
            for (int m = 0; m < 4; ++m) { const size_t r = (size_t)(row0 + ai * HALF + m * 16); float ss = 0.f;
#pragma unroll
                for (int bj = 0; bj < 2; ++bj) { const float* xp = x + r * 1024 + col0 + bj * HALF; float* op = out + r * 1024 + col0 + bj * HALF;
                    f32x4 y0 = *(const f32x4*)xp + g[bj][0] * acc[ai][bj][m][0], y1 = *(const f32x4*)(xp + 4) + g[bj][1] * acc[ai][bj][m][1];
                    *(f32x4*)op = y0; *(f32x4*)(op + 4) = y1;
                    ss += (y0[0] * y0[0] + y0[1] * y0[1]) + (y0[2] * y0[2] + y0[3] * y0[3]) + (y1[0] * y1[0] + y1[1] * y1[1]) + (y1[2] * y1[2] + y1[3] * y1[3]); }
                ss += __shfl_xor(ss, 16); ss += __shfl_xor(ss, 32);
                if (fq == 0) atomicAdd(ROWSS + r, ss); }
    }
};
}

struct Args { const float* in[20]; float* out; unsigned char* ws; };
struct Frame {
    LAS unsigned char* lds; volatile LAS unsigned* MISC; unsigned* ctl;
    int tid, lane, wave, vcu, G, gw, NGW;
    const float *x, *c, *ctx, *c_ctx, *w_mod, *b_mod, *norm_g, *w_in, *gla_up, *gla_ub, *gla_onorm, *gdn_conv, *gdn_a_log, *gdn_dt_bias, *gdn_onorm, *w_gla_out, *w_gdn_out, *b_gate, *w_o, *final_g;
    float* out; unsigned char* ws;
};

__device__ __forceinline__ int in_src_col(int d) {
    if (d < 1024) return d;
    if (d < 2560) return C_BQ + (d - 1024);
    if (d < 2592) return C_ALR + (d - 2560);
    if (d < 2608) return C_BBETA + (d - 2592);
    if (d < 2816) return -1;
    if (d < 3328) return 1024 + (d - 2816);
    if (d < 3840) return C_BG + (d - 3328);
    return C_MG + (d - 3840);
}
template <bool MAP>
__device__ __forceinline__ void p0_transpose_item(const float* W, int K, int ldw, int nblk, bf16* WT, LAS float* scr, int item, int lane) {
    const int kb = item / nblk, nb = item % nblk, k0 = 64 * kb, n0 = 32 * nb;
    const int sc = MAP ? in_src_col(n0 + (lane & 31)) : n0 + (lane & 31);
#pragma unroll 8
    for (int i = 0; i < 32; ++i) { const int kk = 2 * i + (lane >> 5); scr[kk * 33 + (lane & 31)] = sc >= 0 ? W[(size_t)(k0 + kk) * ldw + sc] : 0.f; }
    LDS_WAIT(); asm volatile("" ::: "memory");
    const int c = lane & 7;
#pragma unroll
    for (int j = 0; j < 4; ++j) { const int n = (lane >> 3) + 8 * j; const LAS float* s = scr + (8 * c) * 33 + n;
        v4u o; o.x = pk2(s[0 * 33], s[1 * 33]); o.y = pk2(s[2 * 33], s[3 * 33]); o.z = pk2(s[4 * 33], s[5 * 33]); o.w = pk2(s[6 * 33], s[7 * 33]);
        *(GAS v4u*)(WT + (size_t)(n0 + n) * K + k0 + 8 * c) = o; }
    LDS_WAIT(); asm volatile("" ::: "memory");
}
__device__ __forceinline__ void p0_prologue(Frame& F) {
    LAS float* tab = (LAS float*)(F.lds + 69632);
    for (int i = F.tid; i < 9 * 1024; i += NWAVES * 64) { const int r = i >> 10, k = i & 1023; const float v = r < 8 ? F.c[r * 1024 + k] : F.c_ctx[k]; tab[i] = v / (1.f + __expf(-v)); }
    __syncthreads();
    float* MOD = (float*)(F.ws + WS_MOD);
    for (int it = F.gw; it < 768; it += F.NGW) {
        const int cb = it % 48, ks = it / 48, j = cb * 64 + F.lane; float acc[9];
#pragma unroll
        for (int r = 0; r < 9; ++r) acc[r] = 0.f;
#pragma unroll 8
        for (int kk = 0; kk < 64; ++kk) { const int k = ks * 64 + kk; const float w = F.w_mod[(size_t)k * 3072 + j];
#pragma unroll
            for (int r = 0; r < 9; ++r) acc[r] += tab[r * 1024 + k] * w; }
        const float bias = ks == 0 ? F.b_mod[j] : 0.f;
#pragma unroll
        for (int r = 0; r < 9; ++r) atomicAdd(MOD + r * 3072 + j, acc[r] + bias);
    }
    LAS float* scr = (LAS float*)(F.lds + F.wave * 8704);
    constexpr int I_IN = 16 * (NIN / 32), I_G = 8 * 32, I_O = 16 * 32, NITEMS = I_IN + 2 * I_G + I_O;
    for (int it = F.gw; it < NITEMS; it += F.NGW) {
        int r = it;
        if (r < I_IN) { p0_transpose_item<true>(F.w_in, 1024, D_IN, NIN / 32, (bf16*)(F.ws + WS_WTIN), scr, r, F.lane); continue; } r -= I_IN;
        if (r < I_G) { p0_transpose_item<false>(F.w_gla_out, 512, 1024, 32, (bf16*)(F.ws + WS_WTGA), scr, r, F.lane); continue; } r -= I_G;
        if (r < I_G) { p0_transpose_item<false>(F.w_gdn_out, 512, 1024, 32, (bf16*)(F.ws + WS_WTGD), scr, r, F.lane); continue; } r -= I_G;
        p0_transpose_item<false>(F.w_o, 1024, 1024, 32, (bf16*)(F.ws + WS_WTO), scr, r, F.lane);
    }
}
__device__ __forceinline__ void p1_rows(Frame& F) {
    const float* MOD = (const float*)(F.ws + WS_MOD); bf16* H = (bf16*)(F.ws + WS_H);
    for (int row = F.gw; row < NROWS; row += F.NGW) {
        const float* xr = row < NTOK ? F.x + (size_t)row * DM : F.ctx + (size_t)(row - NTOK) * DM; const int r = row < NTOK ? row / SEQ : BATCH;
        const f32x4* xv = (const f32x4*)xr + F.lane; f32x4 v[4]; float s = 0.f;
#pragma unroll
        for (int j = 0; j < 4; ++j) { v[j] = xv[64 * j]; s += (v[j].x * v[j].x + v[j].y * v[j].y) + (v[j].z * v[j].z + v[j].w * v[j].w); }
        const float rstd = 1.f / sqrtf(wave_sum(s) * (1.f / DM) + EPSV);
        const f32x4* sh = (const f32x4*)(MOD + (size_t)r * 3072) + F.lane; const f32x4* sc = sh + 256; const f32x4* g = (const f32x4*)F.norm_g + F.lane;
        unsigned long long* o8 = (unsigned long long*)(H + (size_t)row * DM) + F.lane;
#pragma unroll
        for (int j = 0; j < 4; ++j) { const f32x4 gg = g[64 * j], cc = sc[64 * j], hh = sh[64 * j]; const f32x4 y = (v[j] * rstd * gg) * (cc + 1.f) + hh;
            o8[64 * j] = (unsigned long long)pk2(y.x, y.y) | ((unsigned long long)pk2(y.z, y.w) << 32); }
    }
}
__device__ __forceinline__ void p3_conv(Frame& F) {
    const bf16* PRE = (const bf16*)(F.ws + WS_PRE); bf16* POST = (bf16*)(F.ws + WS_POST);
    for (int row = F.gw; row < NROWS; row += F.NGW) {
        const bool lat = row < NTOK; int base, t, len;
        if (lat) { base = (row / SEQ) * SEQ; t = row % SEQ; len = SEQ; } else { const int rr = row - NTOK; base = NTOK + (rr / CTXL) * CTXL; t = rr % CTXL; len = CTXL; }
        const int gx = t & 63;
#pragma unroll 1
        for (int wh = 0; wh < 3; ++wh) {
            float acc[8];
#pragma unroll
            for (int e = 0; e < 8; ++e) acc[e] = 0.f;
            const int ch = wh * 512 + 8 * F.lane;
#pragma unroll 1
            for (int dy = (lat ? 0 : 1); dy < (lat ? 3 : 2); ++dy)
#pragma unroll
                for (int dx = 0; dx < 3; ++dx) {
                    int tt; bool ok;
                    if (lat) { const int yy = (t >> 6) + dy - 1, xx = gx + dx - 1; ok = yy >= 0 && yy < SEQ / 64 && xx >= 0 && xx < 64; tt = yy * 64 + xx; }
                    else { tt = t + dx - 1; ok = tt >= 0 && tt < len; }
                    if (!ok) continue;
                    const v4u w = *(const v4u*)(PRE + (size_t)(base + tt) * 1536 + ch); float v[8]; unpack8(w, v);
                    const f32x4* cw = (const f32x4*)(F.gdn_conv + (size_t)(dy * 3 + dx) * 1536 + ch); const f32x4 c0 = cw[0], c1 = cw[1];
#pragma unroll
                    for (int e = 0; e < 4; ++e) { acc[e] += v[e] * c0[e]; acc[4 + e] += v[4 + e] * c1[e]; }
                }
            float ss = 0.f;
#pragma unroll
            for (int e = 0; e < 8; ++e) { acc[e] = fsilu(acc[e]); ss += acc[e] * acc[e]; }
            if (wh < 2) { ss = grp16_sum(ss); float scl = 1.f / sqrtf(ss + EPSV); if (wh == 0) scl *= 0.08838834764831845f;
#pragma unroll
                for (int e = 0; e < 8; ++e) acc[e] *= scl; }
            *(v4u*)(POST + (size_t)row * 1536 + ch) = pack8(acc);
        }
    }
}
__device__ __forceinline__ int scan_row(int b, int dir, int pos, bool& latent) {
    if (pos < CTXL) { latent = false; return NTOK + b * CTXL + (dir ? CTXL - 1 - pos : pos); }
    const int q = pos - CTXL; latent = true; return b * SEQ + (dir ? SEQ - 1 - q : q);
}
__device__ __forceinline__ void p4_scan_naive(Frame& F) {
    const int item = F.vcu; if (item < 128 || F.tid >= 128) return;
    const int e = F.tid, br = item < 192 ? 1 : 0, bid = item & 63, dir = bid & 1, h = (bid >> 1) & 3, b = bid >> 3;
    if (br == 0 ? !DBG_NAIVE_GDN : !DBG_NAIVE_GLA) return;
    const float* SM = (const float*)(F.ws + WS_SM);
    if (br == 0) {
        const bf16* POST = (const bf16*)(F.ws + WS_POST); bf16* O = (bf16*)(F.ws + (dir ? WS_OBB : WS_OBF));
        float S[128];
#pragma unroll
        for (int d = 0; d < 128; ++d) S[d] = 0.f;
        const float A = -expf(F.gdn_a_log[dir * 4 + h]), dtb = F.gdn_dt_bias[dir * 4 + h];
        for (int pos = 0; pos < CTXL + SEQ; ++pos) {
            bool lat; const int row = scan_row(b, dir, pos, lat);
            const v4u* q = (const v4u*)(POST + (size_t)row * 1536 + h * 128); const v4u* k = (const v4u*)(POST + (size_t)row * 1536 + 512 + h * 128);
            const float v = bf2f(POST[(size_t)row * 1536 + 1024 + h * 128 + e]);
            const float beta = 1.f / (1.f + expf(-SM[(size_t)row * NSM + 32 + dir * 4 + h]));
            const float eg = expf(A * softplusf_(SM[(size_t)row * NSM + 40 + dir * 4 + h] + dtb));
            float ks = 0.f;
#pragma unroll
            for (int c = 0; c < 16; ++c) { float kv[8]; unpack8(k[c], kv); if ((c & 3) == 3) asm volatile("" ::: "memory");
#pragma unroll
                for (int j = 0; j < 8; ++j) ks += kv[j] * S[c * 8 + j]; }
            const float vn = beta * (v - eg * ks); float o = 0.f;
#pragma unroll
            for (int c = 0; c < 16; ++c) { float kv[8], qv[8]; unpack8(k[c], kv); unpack8(q[c], qv); if ((c & 1) == 1) asm volatile("" ::: "memory");
#pragma unroll
                for (int j = 0; j < 8; ++j) { S[c * 8 + j] = eg * S[c * 8 + j] + kv[j] * vn; o += qv[j] * S[c * 8 + j]; } }
            if (lat) O[(size_t)row * 512 + h * 128 + e] = (bf16)f2bf(o);
        }
    } else {
        const bf16* AQ = (const bf16*)(F.ws + WS_AQ); const bf16* AK = (const bf16*)(F.ws + WS_AK); const bf16* AV = (const bf16*)((unsigned char*)F.out + DO_DBGAV); bf16* O = (bf16*)(F.ws + (dir ? WS_OAB : WS_OAF));
        float S[64];
#pragma unroll
        for (int d = 0; d < 64; ++d) S[d] = 0.f;
        for (int pos = 0; pos < CTXL + SEQ; ++pos) {
            bool lat; const int row = scan_row(b, dir, pos, lat);
            const float v = bf2f(AV[(size_t)row * 512 + h * 128 + e]);
            float lr[16];
#pragma unroll
            for (int r = 0; r < 16; ++r) lr[r] = SM[(size_t)row * NSM + dir * 16 + r];
            float o = 0.f; int zo = 0; asm volatile("" : "+v"(zo));
#pragma unroll
            for (int d = 0; d < 64; ++d) {
                float u = F.gla_ub[dir * 256 + h * 64 + d + zo];
#pragma unroll
                for (int r = 0; r < 16; ++r) u += lr[r] * F.gla_up[(size_t)(dir * 16 + r) * 256 + h * 64 + d + zo];
                const float dec = expf(logsigf_(u) * (1.f / 16.f));
                S[d] = dec * S[d] + bf2f(AK[(size_t)row * 256 + h * 64 + d]) * v;
                if (lat) o += bf2f(AQ[(size_t)row * 256 + h * 64 + d]) * S[d];
            }
            if (lat) O[(size_t)row * 512 + h * 128 + e] = (bf16)f2bf(o);
        }
    }
}
__device__ __forceinline__ void p5_y(Frame& F) {
    for (int row = F.gw; row < NTOK; row += F.NGW) {
#pragma unroll
        for (int br = 0; br < 2; ++br) {
            const bf16* OF = (const bf16*)(F.ws + (br ? WS_OBF : WS_OAF)); const bf16* OB = (const bf16*)(F.ws + (br ? WS_OBB : WS_OAB));
            const bf16* G = (const bf16*)(F.ws + (br ? WS_BG : WS_AG)); bf16* Y = (bf16*)(F.ws + (br ? WS_YB : WS_YA)); const float* on = br ? F.gdn_onorm : F.gla_onorm;
            const size_t off = (size_t)row * 512 + 8 * F.lane; float a[8], bb[8], g[8];
            unpack8(*(const v4u*)(OF + off), a); unpack8(*(const v4u*)(OB + off), bb); unpack8(*(const v4u*)(G + off), g);
            float ss = 0.f;
#pragma unroll
            for (int e = 0; e < 8; ++e) { a[e] += bb[e]; ss += a[e] * a[e]; }
            ss = grp16_sum(ss); const float rs = 1.f / sqrtf(ss * (1.f / 128.f) + EPSV);
            const f32x4* onv = (const f32x4*)(on + ((8 * F.lane) & 127)); const f32x4 o0 = onv[0], o1 = onv[1];
#pragma unroll
            for (int e = 0; e < 4; ++e) { a[e] = a[e] * rs * o0[e] * g[e]; a[4 + e] = a[4 + e] * rs * o1[e] * g[4 + e]; }
            *(v4u*)(Y + off) = pack8(a);
        }
    }
}
__device__ __forceinline__ void p8_final(Frame& F) {
    const float* ROWSS = (const float*)(F.ws + WS_ROWSS);
    for (int row = F.gw; row < NTOK; row += F.NGW) {
        const float rs = 1.f / sqrtf(ROWSS[row] * (1.f / DM) + EPSV);
        f32x4* y = (f32x4*)(F.out + (size_t)row * DM) + F.lane; const f32x4* g = (const f32x4*)F.final_g + F.lane;
#pragma unroll
        for (int j = 0; j < 4; ++j) y[64 * j] = y[64 * j] * rs * g[64 * j];
    }
}

typedef short bf16x8_t __attribute__((ext_vector_type(8)));
typedef float f4 __attribute__((ext_vector_type(4)));
#define MFMA16(a, b, c) __builtin_amdgcn_mfma_f32_16x16x32_bf16((a), (b), (c), 0, 0, 0)
constexpr int NCH = 36;
constexpr int NITEM = BATCH * 4 * NCH;
__device__ __forceinline__ int chunk_row0(int b, int cid) { return cid < 4 ? NTOK + b * CTXL + cid * 64 : b * SEQ + (cid - 4) * 64; }
__device__ __forceinline__ int step_cid(int dir, int s) { return dir ? (s < 4 ? 3 - s : 35 - (s - 4)) : s; }
__device__ __forceinline__ unsigned cvtpk(float lo, float hi) { unsigned r; asm volatile("v_cvt_pk_bf16_f32 %0, %1, %2" : "=v"(r) : "v"(lo), "v"(hi)); return r; }
__device__ __forceinline__ int img_off_perm(int row, int k, int nks) { const int o = k & 31; return (((row >> 4) * nks + (k >> 5)) * 64 + (((o & 15) >> 2) << 4) + (row & 15)) * 8 + (o & 3) + ((o >> 4) << 2); }
__device__ __forceinline__ int img_off_nat(int row, int k, int nks) { const int o = k & 31; return (((row >> 4) * nks + (k >> 5)) * 64 + ((o >> 3) << 4) + (row & 15)) * 8 + (o & 7); }

__device__ __forceinline__ void p3a_conv_item(Frame& F, int item) {
    const int cid = item % NCH, h = (item / NCH) & 3, b = item / (NCH * 4); const bool lat = cid >= 4;
    const bf16* PRE = (const bf16*)(F.ws + WS_PRE);
    bf16* KIMG = (bf16*)(F.ws + WS_KIMG) + (size_t)item * 8192; bf16* KTIMG = (bf16*)(F.ws + WS_KTIMG) + (size_t)item * 8192; bf16* VT = (bf16*)(F.ws + WS_VT) + (size_t)item * 8192;
    bf16* QIMG = (bf16*)((unsigned char*)F.out + DO_QIMG) + (size_t)(lat ? ((b * 4 + h) * 32 + cid - 4) : 0) * 8192;
    const int row0 = chunk_row0(b, cid); const int l16 = F.tid & 15;
#pragma unroll 1
    for (int it = (lat ? 0 : 2); it < 6; ++it) {
        const int wh = it >> 1, p = (F.tid >> 4) + 32 * (it & 1);
        const int ch = wh * 512 + h * 128 + 8 * l16;
        float acc[8];
#pragma unroll
        for (int e = 0; e < 8; ++e) acc[e] = 0.f;
#pragma unroll 1
        for (int dy = (lat ? 0 : 1); dy < (lat ? 3 : 2); ++dy)
#pragma unroll
            for (int dx = 0; dx < 3; ++dx) {
                int nrow; bool ok;
                if (lat) { const int yy = cid - 4 + dy - 1, xx = p + dx - 1; ok = yy >= 0 && yy < 32 && xx >= 0 && xx < 64; nrow = b * SEQ + yy * 64 + xx; }
                else { const int tt = cid * 64 + p + dx - 1; ok = tt >= 0 && tt < CTXL; nrow = NTOK + b * CTXL + tt; }
                if (!ok) continue;
                const v4u w = *(const v4u*)(PRE + (size_t)nrow * 1536 + ch); float v[8]; unpack8(w, v);
                const f32x4* cw = (const f32x4*)(F.gdn_conv + (size_t)(dy * 3 + dx) * 1536 + ch); const f32x4 c0 = cw[0], c1 = cw[1];
#pragma unroll
                for (int e = 0; e < 4; ++e) { acc[e] += v[e] * c0[e]; acc[4 + e] += v[4 + e] * c1[e]; }
            }
        float ss = 0.f;
#pragma unroll
        for (int e = 0; e < 8; ++e) { acc[e] = fsilu(acc[e]); ss += acc[e] * acc[e]; }
        if (wh < 2) { ss = grp16_sum(ss); float scl = 1.f / sqrtf(ss + EPSV); if (wh == 0) scl *= 0.08838834764831845f;
#pragma unroll
            for (int e = 0; e < 8; ++e) acc[e] *= scl; }
        const unsigned w0 = pk2(acc[0], acc[1]), w1 = pk2(acc[2], acc[3]), w2 = pk2(acc[4], acc[5]), w3 = pk2(acc[6], acc[7]);
        if (wh < 2) {
            bf16* IMG = wh == 0 ? QIMG : KIMG;
            *(v2u*)(IMG + img_off_perm(p, 8 * l16, 4)) = (v2u){w0, w1};
            *(v2u*)(IMG + img_off_perm(p, 8 * l16 + 4, 4)) = (v2u){w2, w3};
        }
        if (wh == 1) {
#pragma unroll
            for (int e = 0; e < 8; ++e) KTIMG[img_off_perm(8 * l16 + e, p, 2)] = (bf16)f2bf(acc[e]);
        }
        if (wh == 2) {
#pragma unroll
            for (int e = 0; e < 8; ++e) VT[(8 * l16 + e) * 64 + p] = (bf16)f2bf(acc[e]);
        }
    }
}
__device__ __forceinline__ float wave_prefix(float v, int lane) {
#pragma unroll
    for (int o = 1; o < 64; o <<= 1) { const float t = __shfl_up(v, o); if (lane >= o) v += t; }
    return v;
}
__device__ __forceinline__ v4u lds_frag_perm(const LAS bf16* t, int LD, int row0, int k0, int lane) {
    const LAS bf16* p = t + (row0 + (lane & 15)) * LD + k0 + 4 * (lane >> 4); const v2u a = *(const LAS v2u*)p, b = *(const LAS v2u*)(p + 16); return (v4u){a.x, a.y, b.x, b.y};
}
__device__ __forceinline__ v4u lds_frag_nat(const LAS bf16* t, int LD, int row0, int k0, int lane) {
    return *(const LAS v4u*)(t + (row0 + (lane & 15)) * LD + k0 + 8 * (lane >> 4));
}
__device__ __forceinline__ void p3b_gdn(Frame& F, int item, int dir, LAS unsigned char* scr) {
    const int lane = F.lane, cid = item % NCH, h = (item / NCH) & 3, b = item / (NCH * 4); const bool lat = cid >= 4;
    const int row0 = chunk_row0(b, cid);
    const float* SM = (const float*)(F.ws + WS_SM);
    const float beta = 1.f / (1.f + expf(-SM[(size_t)(row0 + lane) * NSM + 32 + dir * 4 + h]));
    const float g = -expf(F.gdn_a_log[dir * 4 + h]) * softplusf_(SM[(size_t)(row0 + lane) * NSM + 40 + dir * 4 + h] + F.gdn_dt_bias[dir * 4 + h]);
    float gam; { const float gs = dir ? __shfl(g, 63 - lane) : g; const float pf = wave_prefix(gs, lane); gam = dir ? __shfl(pf, 63 - lane) : pf; }
    const float gl = __shfl(gam, dir ? 0 : 63);
    float* SC = (float*)(F.ws + WS_SCAL) + (size_t)(item * 2 + dir) * 192;
    SC[lane] = expf(gam); SC[64 + lane] = expf(gl - gam); if (lane == 0) SC[128] = expf(gl);
    const bf16* KIMG = (const bf16*)(F.ws + WS_KIMG) + (size_t)item * 8192;
    const bf16* QIMG = (const bf16*)((unsigned char*)F.out + DO_QIMG) + (size_t)(lat ? ((b * 4 + h) * 32 + cid - 4) : 0) * 8192;
    LAS float* As = (LAS float*)scr;
    const int c = lane & 15, q = lane >> 4;
#pragma unroll 1
    for (int rt = 0; rt < 4; ++rt)
#pragma unroll 1
        for (int ct = 0; ct < 4; ++ct) {
            if (dir ? (ct < rt) : (ct > rt)) continue;
            f4 acc = {0.f, 0.f, 0.f, 0.f};
#pragma unroll
            for (int ks = 0; ks < 4; ++ks) { const bf16x8_t a = *(const bf16x8_t*)(KIMG + ((rt * 4 + ks) * 64 + lane) * 8), bb = *(const bf16x8_t*)(KIMG + ((ct * 4 + ks) * 64 + lane) * 8); acc = MFMA16(a, bb, acc); }
            const int pc = 16 * ct + c; const float gc = __shfl(gam, pc);
#pragma unroll
            for (int i = 0; i < 4; ++i) { const int pr = 16 * rt + 4 * q + i; const float gr = __shfl(gam, pr), br = __shfl(beta, pr);
                const bool keep = dir ? (pc > pr) : (pc < pr);
                const float v = keep ? br * acc[i] * expf(gr - gc) : 0.f;
                As[(dir ? 63 - pr : pr) * 64 + (dir ? 63 - pc : pc)] = v; }
        }
    LDS_WAIT();
    float T[64];
#pragma unroll
    for (int i = 0; i < 64; ++i) {
        if ((i & 3) == 0) asm volatile("" ::: "memory");
        float a0 = (lane == i) ? 1.f : 0.f, a1 = 0.f;
#pragma unroll
        for (int j4 = 0; j4 < i; j4 += 4) { const f4 ar = *(const LAS f4*)(As + i * 64 + j4);
            a0 -= ar[0] * T[j4]; if (j4 + 1 < i) a1 -= ar[1] * T[j4 + 1]; if (j4 + 2 < i) a0 -= ar[2] * T[j4 + 2]; if (j4 + 3 < i) a1 -= ar[3] * T[j4 + 3]; }
        T[i] = a0 + a1;
    }
    asm volatile("" ::: "memory");
    const int pcol = dir ? 63 - lane : lane; const float bcol = __shfl(beta, pcol);
    LAS bf16* Tt = (LAS bf16*)scr;
#pragma unroll
    for (int i = 0; i < 64; ++i) Tt[(dir ? 63 - i : i) * 72 + pcol] = (bf16)f2bf(T[i] * bcol);
    LDS_WAIT();
    bf16* TBIMG = (bf16*)(F.ws + WS_TBIMG) + (size_t)(item * 2 + dir) * 4096;
#pragma unroll
    for (int fr = 0; fr < 8; ++fr) *(v4u*)(TBIMG + (fr * 64 + lane) * 8) = lds_frag_perm(Tt, 72, (fr >> 1) * 16, (fr & 1) * 32, lane);
    if (!lat) return;
    LDS_WAIT();
    LAS bf16* Aq = (LAS bf16*)scr;
#pragma unroll 1
    for (int rt = 0; rt < 4; ++rt)
#pragma unroll 1
        for (int ct = 0; ct < 4; ++ct) {
            f4 acc = {0.f, 0.f, 0.f, 0.f};
            const bool need = dir ? (ct >= rt) : (ct <= rt);
            if (need) {
#pragma unroll
                for (int ks = 0; ks < 4; ++ks) { const bf16x8_t a = *(const bf16x8_t*)(QIMG + ((rt * 4 + ks) * 64 + lane) * 8), bb = *(const bf16x8_t*)(KIMG + ((ct * 4 + ks) * 64 + lane) * 8); acc = MFMA16(a, bb, acc); }
            }
            const int pc = 16 * ct + c; const float gc = __shfl(gam, pc);
#pragma unroll
            for (int i = 0; i < 4; ++i) { const int pr = 16 * rt + 4 * q + i; const float gr = __shfl(gam, pr);
                const bool keep = need && (dir ? (pc >= pr) : (pc <= pr));
                Aq[pr * 72 + pc] = (bf16)f2bf(keep ? acc[i] * expf(gr - gc) : 0.f); }
        }
    LDS_WAIT();
    bf16* AQKIMG = (bf16*)((unsigned char*)F.out + DO_AQKIMG) + (size_t)(((b * 4 + h) * 32 + cid - 4) * 2 + dir) * 4096;
#pragma unroll
    for (int fr = 0; fr < 8; ++fr) *(v4u*)(AQKIMG + (fr * 64 + lane) * 8) = lds_frag_perm(Aq, 72, (fr >> 1) * 16, (fr & 1) * 32, lane);
    LDS_WAIT();
}
__device__ __forceinline__ float gla_alog(const float* lr, const float (&up)[16], float ub) {
    float u = ub;
#pragma unroll
    for (int r = 0; r < 16; ++r) u += lr[r] * up[r];
    return (fminf(u, 0.f) - __logf(1.f + __expf(-fabsf(u)))) * (1.f / 16.f);
}
__device__ __forceinline__ void p3b_gla(Frame& F, int item, int dir, LAS unsigned char* scr) {
    const int lane = F.lane, cid = item % NCH, h = (item / NCH) & 3, b = item / (NCH * 4); const bool lat = cid >= 4;
    const int row0 = chunk_row0(b, cid);
    const float* SM = (const float*)(F.ws + WS_SM) + (size_t)row0 * NSM + dir * 16; const bf16* AQ = (const bf16*)(F.ws + WS_AQ) + (size_t)row0 * 256 + h * 64 + lane;
    const bf16* AK = (const bf16*)(F.ws + WS_AK) + (size_t)row0 * 256 + h * 64 + lane;
    float up[16];
#pragma unroll
    for (int r = 0; r < 16; ++r) up[r] = F.gla_up[(size_t)(dir * 16 + r) * 256 + h * 64 + lane];
    const float ub = F.gla_ub[dir * 256 + h * 64 + lane];
    float bl = 0.f;
#pragma unroll 2
    for (int p = 0; p < 64; ++p) bl += gla_alog(SM + p * NSM, up, ub);
    ((float*)(F.ws + WS_EBL))[(size_t)(item * 2 + dir) * 64 + lane] = __expf(bl);
    LAS bf16* Qe = (LAS bf16*)scr; LAS bf16* Ke = (LAS bf16*)(scr + 9216);
    bf16* KDTIMG = (bf16*)(F.ws + WS_KDTIMG) + (size_t)(item * 2 + dir) * 4096;
    float run = 0.f;
#pragma unroll 1
    for (int s8 = 0; s8 < 8; ++s8) { float kd[8], ko[8];
#pragma unroll
        for (int e = 0; e < 8; ++e) { const int sidx = s8 * 8 + e; const int p = dir ? 63 - sidx : sidx;
            run += gla_alog(SM + p * NSM, up, ub); const float eb = __expf(run); const float kk = bf2f(AK[p * 256]); const float qq = lat ? bf2f(AQ[p * 256]) : 0.f;
            Qe[p * 72 + lane] = (bf16)f2bf(qq * eb); Ke[p * 72 + lane] = (bf16)f2bf(kk * __builtin_amdgcn_rcpf(eb)); kd[e] = kk * __expf(bl - run); }
#pragma unroll
        for (int e = 0; e < 8; ++e) ko[e] = dir ? kd[7 - e] : kd[e];
        const int p0 = (dir ? 7 - s8 : s8) * 8;
        *(v4u*)(KDTIMG + (((lane >> 4) * 2 + (p0 >> 5)) * 64 + (((p0 & 31) >> 3) << 4) + (lane & 15)) * 8) = pack8(ko); }
    LDS_WAIT();
    if (!lat) return;
    const int c = lane & 15, q = lane >> 4;
    bf16* QEIMG = (bf16*)((unsigned char*)F.out + DO_QEIMG) + (size_t)(((b * 4 + h) * 32 + cid - 4) * 2 + dir) * 4096;
#pragma unroll
    for (int fr = 0; fr < 8; ++fr) *(v4u*)(QEIMG + (fr * 64 + lane) * 8) = lds_frag_perm(Qe, 72, (fr >> 1) * 16, (fr & 1) * 32, lane);
    f4 att[4][4];
#pragma unroll
    for (int rt = 0; rt < 4; ++rt)
#pragma unroll
        for (int ct = 0; ct < 4; ++ct) { f4 acc = {0.f, 0.f, 0.f, 0.f};
            if (dir ? (ct >= rt) : (ct <= rt)) {
#pragma unroll
                for (int ks = 0; ks < 2; ++ks) { const v4u a = lds_frag_nat(Qe, 72, rt * 16, ks * 32, lane), bb = lds_frag_nat(Ke, 72, ct * 16, ks * 32, lane);
                    acc = MFMA16(__builtin_bit_cast(bf16x8_t, a), __builtin_bit_cast(bf16x8_t, bb), acc); } }
            att[rt][ct] = acc; }
    LDS_WAIT();
    LAS bf16* At = (LAS bf16*)scr;
#pragma unroll
    for (int rt = 0; rt < 4; ++rt)
#pragma unroll
        for (int ct = 0; ct < 4; ++ct) { const int pc = 16 * ct + c;
#pragma unroll
            for (int i = 0; i < 4; ++i) { const int pr = 16 * rt + 4 * q + i; const bool keep = dir ? (pc >= pr) : (pc <= pr);
                At[pr * 72 + pc] = (bf16)f2bf(keep ? att[rt][ct][i] : 0.f); } }
    LDS_WAIT();
    bf16* ATTIMG = (bf16*)((unsigned char*)F.out + DO_ATTIMG) + (size_t)(((b * 4 + h) * 32 + cid - 4) * 2 + dir) * 4096;
#pragma unroll
    for (int fr = 0; fr < 8; ++fr) *(v4u*)(ATTIMG + (fr * 64 + lane) * 8) = lds_frag_nat(At, 72, (fr >> 1) * 16, (fr & 1) * 32, lane);
    LDS_WAIT();
}
__device__ __forceinline__ void p3_prep(Frame& F) {
    int nit = 0;
    for (int item = F.vcu; item < NITEM; item += F.G) {
#if !DBG_NAIVE_GDN
        p3a_conv_item(F, item);
#endif
        ++nit; }
    VM_WAIT(); __syncthreads();
    LAS unsigned char* scr = F.lds + F.wave * 18432;
#pragma unroll 1
    for (int idx = F.wave; idx < nit * 4; idx += NWAVES) {
        const int item = F.vcu + (idx >> 2) * F.G, kind = (idx >> 1) & 1, dir = idx & 1;
        if (kind == 0) {
#if !DBG_NAIVE_GDN
            p3b_gdn(F, item, dir, scr);
#endif
        } else {
#if !DBG_NAIVE_GLA
            p3b_gla(F, item, dir, scr);
#endif
        }
    }
}

__device__ __forceinline__ void glds1k(const bf16* g, LAS unsigned char* l, int lane) { __builtin_amdgcn_global_load_lds((const unsigned*)(g + lane * 8), (LAS unsigned*)l, 16, 0, 0); }
__device__ __forceinline__ void gdn_stage(Frame& F, int b, int h, int dir, int s) {
    const int cid = step_cid(dir, s), item = (b * 4 + h) * NCH + cid; const bool lat = cid >= 4; const size_t li = (size_t)(lat ? ((b * 4 + h) * 32 + cid - 4) : 0);
    LAS unsigned char* buf = F.lds + (s & 1) * 65536;
#pragma unroll
    for (int k = 0; k < 8; ++k) { const int fr = 8 * F.wave + k; const bf16* src;
        if (fr < 16) src = (const bf16*)(F.ws + WS_KIMG) + (size_t)item * 8192 + fr * 512;
        else if (fr < 32) { if (!lat) continue; src = (const bf16*)((unsigned char*)F.out + DO_QIMG) + li * 8192 + (fr - 16) * 512; }
        else if (fr < 48) src = (const bf16*)(F.ws + WS_KTIMG) + (size_t)item * 8192 + (fr - 32) * 512;
        else if (fr < 56) src = (const bf16*)(F.ws + WS_TBIMG) + (size_t)(item * 2 + dir) * 4096 + (fr - 48) * 512;
        else { if (!lat) continue; src = (const bf16*)((unsigned char*)F.out + DO_AQKIMG) + (li * 2 + dir) * 4096 + (fr - 56) * 512; }
        glds1k(src, buf + fr * 1024, F.lane); }
}
__device__ __forceinline__ void gla_stage(Frame& F, int b, int h, int dir, int s) {
    const int cid = step_cid(dir, s), item = (b * 4 + h) * NCH + cid; const bool lat = cid >= 4; const size_t li = (size_t)(lat ? ((b * 4 + h) * 32 + cid - 4) : 0);
    LAS unsigned char* buf = F.lds + (s & 1) * 32768;
#pragma unroll
    for (int k = 0; k < 3; ++k) { const int fr = 3 * F.wave + k; const bf16* src;
        if (fr < 8) { if (!lat) continue; src = (const bf16*)((unsigned char*)F.out + DO_QEIMG) + (li * 2 + dir) * 4096 + fr * 512; }
        else if (fr < 16) { if (!lat) continue; src = (const bf16*)((unsigned char*)F.out + DO_ATTIMG) + (li * 2 + dir) * 4096 + (fr - 8) * 512; }
        else src = (const bf16*)(F.ws + WS_KDTIMG) + (size_t)(item * 2 + dir) * 4096 + (fr - 16) * 512;
        glds1k(src, buf + fr * 1024, F.lane); }
}
__device__ __forceinline__ void p4_gdn(Frame& F, int idx) {
    const int half = idx & 1, dir = (idx >> 1) & 1, h = (idx >> 2) & 3, b = idx >> 4; const int lane = F.lane, w = F.wave, c = lane & 15, q = lane >> 4;
    const int col = half * 64 + 16 * (w & 3) + c;
    bf16* O = (bf16*)(F.ws + (dir ? WS_OBB : WS_OBF));
    f4 S[8];
#pragma unroll
    for (int u = 0; u < 8; ++u) S[u] = (f4){0.f, 0.f, 0.f, 0.f};
    gdn_stage(F, b, h, dir, 0); VM_WAIT(); __syncthreads();
#pragma unroll 1
    for (int s = 0; s < NCH; ++s) {
        if (s + 1 < NCH) gdn_stage(F, b, h, dir, s + 1);
        if (w < 4) {
            const int cid = step_cid(dir, s), item = (b * 4 + h) * NCH + cid; const bool lat = cid >= 4;
            const LAS unsigned char* buf = F.lds + (s & 1) * 65536;
            const float* SC = (const float*)(F.ws + WS_SCAL) + (size_t)(item * 2 + dir) * 192;
            const bf16* VTp = (const bf16*)(F.ws + WS_VT) + (size_t)item * 8192 + col * 64;
            f4 eg[4], egl[4], V[4];
#pragma unroll
            for (int rt = 0; rt < 4; ++rt) { eg[rt] = *(const f4*)(SC + 16 * rt + 4 * q); egl[rt] = *(const f4*)(SC + 64 + 16 * rt + 4 * q);
                const v2u vv = *(const v2u*)(VTp + 16 * rt + 4 * q); V[rt] = (f4){bflo(vv.x), bfhi(vv.x), bflo(vv.y), bfhi(vv.y)}; }
            const float egt = SC[128];
            bf16x8_t Bs[4];
#pragma unroll
            for (int ks = 0; ks < 4; ++ks) { const v4u t = {cvtpk(S[2 * ks][0], S[2 * ks][1]), cvtpk(S[2 * ks][2], S[2 * ks][3]), cvtpk(S[2 * ks + 1][0], S[2 * ks + 1][1]), cvtpk(S[2 * ks + 1][2], S[2 * ks + 1][3])}; Bs[ks] = __builtin_bit_cast(bf16x8_t, t); }
            f4 KS[4], QS[4];
#pragma unroll
            for (int rt = 0; rt < 4; ++rt) { f4 a = {0.f, 0.f, 0.f, 0.f}, a2 = {0.f, 0.f, 0.f, 0.f};
#pragma unroll
                for (int ks = 0; ks < 4; ++ks) { a = MFMA16(*(const LAS bf16x8_t*)(buf + ((rt * 4 + ks) * 64 + lane) * 16), Bs[ks], a);
                    if (lat) a2 = MFMA16(*(const LAS bf16x8_t*)(buf + 16384 + ((rt * 4 + ks) * 64 + lane) * 16), Bs[ks], a2); }
                KS[rt] = a; QS[rt] = a2; }
            f4 R[4];
#pragma unroll
            for (int rt = 0; rt < 4; ++rt) R[rt] = V[rt] - eg[rt] * KS[rt];
            bf16x8_t Br[2];
#pragma unroll
            for (int ks = 0; ks < 2; ++ks) { const v4u t = {cvtpk(R[2 * ks][0], R[2 * ks][1]), cvtpk(R[2 * ks][2], R[2 * ks][3]), cvtpk(R[2 * ks + 1][0], R[2 * ks + 1][1]), cvtpk(R[2 * ks + 1][2], R[2 * ks + 1][3])}; Br[ks] = __builtin_bit_cast(bf16x8_t, t); }
            f4 Vp[4];
#pragma unroll
            for (int rt = 0; rt < 4; ++rt) { f4 a = {0.f, 0.f, 0.f, 0.f};
#pragma unroll
                for (int ks = 0; ks < 2; ++ks) a = MFMA16(*(const LAS bf16x8_t*)(buf + 49152 + ((rt * 2 + ks) * 64 + lane) * 16), Br[ks], a);
                Vp[rt] = a; }
            bf16x8_t Bv[2], Bw[2];
#pragma unroll
            for (int ks = 0; ks < 2; ++ks) { const f4 x0 = Vp[2 * ks], x1 = Vp[2 * ks + 1], y0 = x0 * egl[2 * ks], y1 = x1 * egl[2 * ks + 1];
                const v4u t = {cvtpk(x0[0], x0[1]), cvtpk(x0[2], x0[3]), cvtpk(x1[0], x1[1]), cvtpk(x1[2], x1[3])}; Bv[ks] = __builtin_bit_cast(bf16x8_t, t);
                const v4u t2 = {cvtpk(y0[0], y0[1]), cvtpk(y0[2], y0[3]), cvtpk(y1[0], y1[1]), cvtpk(y1[2], y1[3])}; Bw[ks] = __builtin_bit_cast(bf16x8_t, t2); }
            if (lat) {
                const int trow0 = chunk_row0(b, cid);
#pragma unroll
                for (int rt = 0; rt < 4; ++rt) { f4 a = eg[rt] * QS[rt];
#pragma unroll
                    for (int ks = 0; ks < 2; ++ks) a = MFMA16(*(const LAS bf16x8_t*)(buf + 57344 + ((rt * 2 + ks) * 64 + lane) * 16), Bv[ks], a);
#pragma unroll
                    for (int i = 0; i < 4; ++i) O[(size_t)(trow0 + 16 * rt + 4 * q + i) * 512 + h * 128 + col] = (bf16)f2bf(a[i]); }
            }
#pragma unroll
            for (int u = 0; u < 8; ++u) { f4 a = S[u] * egt;
#pragma unroll
                for (int ks = 0; ks < 2; ++ks) a = MFMA16(*(const LAS bf16x8_t*)(buf + 32768 + ((u * 2 + ks) * 64 + lane) * 16), Bw[ks], a);
                S[u] = a; }
        }
        VM_WAIT(); __syncthreads();
    }
}
__device__ __forceinline__ void p4_gla(Frame& F, int idx) {
    const int dir = idx & 1, h = (idx >> 1) & 3, b = idx >> 3; const int lane = F.lane, w = F.wave, c = lane & 15, q = lane >> 4;
    const int col = 16 * w + c;
    bf16* O = (bf16*)(F.ws + (dir ? WS_OAB : WS_OAF));
    f4 S[4];
#pragma unroll
    for (int u = 0; u < 4; ++u) S[u] = (f4){0.f, 0.f, 0.f, 0.f};
    gla_stage(F, b, h, dir, 0); VM_WAIT(); __syncthreads();
#pragma unroll 1
    for (int s = 0; s < NCH; ++s) {
        if (s + 1 < NCH) gla_stage(F, b, h, dir, s + 1);
        {
            const int cid = step_cid(dir, s), item = (b * 4 + h) * NCH + cid; const bool lat = cid >= 4;
            const LAS unsigned char* buf = F.lds + (s & 1) * 32768;
            const float* EB = (const float*)(F.ws + WS_EBL) + (size_t)(item * 2 + dir) * 64;
            const bf16* VTp = (const bf16*)(F.ws + WS_VTA) + (size_t)item * 8192 + col * 64;
            bf16x8_t Bv[2];
#pragma unroll
            for (int ks = 0; ks < 2; ++ks) Bv[ks] = *(const bf16x8_t*)(VTp + 32 * ks + 8 * q);
            if (lat) {
                bf16x8_t Bs[2];
#pragma unroll
                for (int ks = 0; ks < 2; ++ks) { const v4u t = {cvtpk(S[2 * ks][0], S[2 * ks][1]), cvtpk(S[2 * ks][2], S[2 * ks][3]), cvtpk(S[2 * ks + 1][0], S[2 * ks + 1][1]), cvtpk(S[2 * ks + 1][2], S[2 * ks + 1][3])}; Bs[ks] = __builtin_bit_cast(bf16x8_t, t); }
                const int trow0 = chunk_row0(b, cid);
#pragma unroll
                for (int rt = 0; rt < 4; ++rt) { f4 a = {0.f, 0.f, 0.f, 0.f};
#pragma unroll
                    for (int ks = 0; ks < 2; ++ks) { a = MFMA16(*(const LAS bf16x8_t*)(buf + ((rt * 2 + ks) * 64 + lane) * 16), Bs[ks], a);
                        a = MFMA16(*(const LAS bf16x8_t*)(buf + 8192 + ((rt * 2 + ks) * 64 + lane) * 16), Bv[ks], a); }
#pragma unroll
                    for (int i = 0; i < 4; ++i) O[(size_t)(trow0 + 16 * rt + 4 * q + i) * 512 + h * 128 + col] = (bf16)f2bf(a[i]); }
            }
#pragma unroll
            for (int u = 0; u < 4; ++u) { f4 a = S[u] * *(const f4*)(EB + 16 * u + 4 * q);
#pragma unroll
                for (int ks = 0; ks < 2; ++ks) a = MFMA16(*(const LAS bf16x8_t*)(buf + 16384 + ((u * 2 + ks) * 64 + lane) * 16), Bv[ks], a);
                S[u] = a; }
        }
        VM_WAIT(); __syncthreads();
    }
}

__global__ void __launch_bounds__(NWAVES * 64, 2) mk_fwd(Args args) {
    extern __shared__ __attribute__((aligned(16))) unsigned char lds[];
    Frame F;
    F.lds = (LAS unsigned char*)lds; F.MISC = (volatile LAS unsigned*)(F.lds + MISC_OFF);
    F.tid = threadIdx.x; F.lane = F.tid & 63; F.wave = __builtin_amdgcn_readfirstlane(F.tid >> 6);
    F.G = gridDim.x; { const int bx = blockIdx.x; F.vcu = (F.G % 8 == 0) ? (bx % 8) * (F.G / 8) + bx / 8 : bx; }
    F.gw = F.vcu * NWAVES + F.wave; F.NGW = F.G * NWAVES;
    F.ws = args.ws; F.out = args.out; F.ctl = (unsigned*)(args.ws + WS_CTL);
    F.x = args.in[0]; F.c = args.in[1]; F.ctx = args.in[2]; F.c_ctx = args.in[3]; F.w_mod = args.in[4]; F.b_mod = args.in[5]; F.norm_g = args.in[6]; F.w_in = args.in[7];
    F.gla_up = args.in[8]; F.gla_ub = args.in[9]; F.gla_onorm = args.in[10]; F.gdn_conv = args.in[11]; F.gdn_a_log = args.in[12]; F.gdn_dt_bias = args.in[13]; F.gdn_onorm = args.in[14];
    F.w_gla_out = args.in[15]; F.w_gdn_out = args.in[16]; F.b_gate = args.in[17]; F.w_o = args.in[18]; F.final_g = args.in[19];
    for (int u = F.tid; u < (LDS_BYTES - MISC_OFF) / 4; u += NWAVES * 64) ((LAS unsigned*)(F.lds + MISC_OFF))[u] = 0u;
    __syncthreads();
    XcdBarrier bar = xcd_barrier_post(F.ctl + CW_BAR, F.MISC + 8);
#define GRID_BAR() xcd_barrier(bar)
    unsigned char* ws = args.ws;
    bf16* H = (bf16*)(ws + WS_H);
    p0_prologue(F); GRID_BAR();
    p1_rows(F); GRID_BAR();
    {   pg8::Gemm g{H, (const bf16*)(ws + WS_WTIN), NROWS, 11 * 256, DM}; pg8::OrderA S; S.init(F.G, (int)blockIdx.x);
        pg8::EpiIn E{ws, (bf16*)args.out, (float*)(ws + WS_SM), F.b_gate, 0};
        pg8::gemm_phase<pg8::EpiIn, pg8::OrderA, PG8_ALIGN, PG8_SP2>(F.lds, g, S, E); }
    GRID_BAR();
#if DBG_NAIVE_GDN
    p3_conv(F);
#endif
    p3_prep(F); GRID_BAR();
    if (F.vcu < 128) {
#if !DBG_NAIVE_GDN
        p4_gdn(F, F.vcu);
#endif
    } else if (F.vcu < 192) {
#if !DBG_NAIVE_GLA
        p4_gla(F, F.vcu - 128);
#endif
    }
#if DBG_NAIVE_GDN || DBG_NAIVE_GLA
    p4_scan_naive(F);
#endif
    GRID_BAR();
    {   pg8::Gemm g{H, (const bf16*)(ws + WS_WTIN) + (size_t)2816 * DM, NTOK, 12 * 256, DM}; pg8::StaticOrder S; S.init(NTOK, 12 * 256, F.G, (int)blockIdx.x);
        pg8::EpiIn E{ws, (bf16*)args.out, (float*)(ws + WS_SM), F.b_gate, 11};
        pg8::gemm_phase<pg8::EpiIn, pg8::StaticOrder, PG8_ALIGN, PG8_SP2>(F.lds, g, S, E); }
    GRID_BAR();
    p5_y(F); GRID_BAR();
    {   pg8::Gemm g{(const bf16*)(ws + WS_YA), (const bf16*)(ws + WS_WTGA), NTOK, DM, 512}; pg8::StaticOrder S; S.init(NTOK, DM, F.G, (int)blockIdx.x);
        pg8::EpiGa E{(const bf16*)args.out, (float*)(ws + WS_TMP)};
        pg8::gemm_phase<pg8::EpiGa, pg8::StaticOrder, PG8_ALIGN, PG8_SP2>(F.lds, g, S, E); }
    GRID_BAR();
    {   pg8::Gemm g{(const bf16*)(ws + WS_YB), (const bf16*)(ws + WS_WTGD), NTOK, DM, 512}; pg8::StaticOrder S; S.init(NTOK, DM, F.G, (int)blockIdx.x);
        pg8::EpiGb E{(const bf16*)args.out, (const float*)(ws + WS_TMP), (bf16*)(ws + WS_MERGED)};
        pg8::gemm_phase<pg8::EpiGb, pg8::StaticOrder, PG8_ALIGN, PG8_SP2>(F.lds, g, S, E); }
    GRID_BAR();
    {   pg8::Gemm g{(const bf16*)(ws + WS_MERGED), (const bf16*)(ws + WS_WTO), NTOK, DM, DM}; pg8::StaticOrder S; S.init(NTOK, DM, F.G, (int)blockIdx.x);
        pg8::EpiOut E{F.x, (const float*)(ws + WS_MOD), args.out, (float*)(ws + WS_ROWSS)};
        pg8::gemm_phase<pg8::EpiOut, pg8::StaticOrder, PG8_ALIGN, PG8_SP2>(F.lds, g, S, E); }
    GRID_BAR();
    p8_final(F);
}

extern "C" void kernel_launch(void* const* d_in, const int* in_sizes, int n_in, void* d_out, int out_size, void* d_ws, size_t ws_size, hipStream_t stream) {
    static int grid = 0;
    if (grid == 0) {
        if (n_in != 20 || out_size != NTOK * DM || ws_size < WS_END) { fprintf(stderr, "kernel_launch: unexpected shapes (n_in %d, out %d, ws %zu); nothing launched\n", n_in, out_size, ws_size); grid = -1; return; }
        int dev = 0, cus = 0;
        if (hipGetDevice(&dev) != hipSuccess || hipDeviceGetAttribute(&cus, hipDeviceAttributeMultiprocessorCount, dev) != hipSuccess) { grid = -1; return; }
        if (hipFuncSetAttribute((const void*)mk_fwd, hipFuncAttributeMaxDynamicSharedMemorySize, LDS_BYTES) != hipSuccess) { fprintf(stderr, "kernel_launch: hipFuncSetAttribute failed\n"); grid = -1; return; }
        (void)hipGetLastError();
        grid = cus;
    }
    if (grid < 0) return;
    if (hipMemsetAsync((char*)d_ws + WS_CTL, 0, CTL_ZERO_BYTES, stream) != hipSuccess) { fprintf(stderr, "kernel_launch: memset failed\n"); return; }
    Args a{};
    for (int i = 0; i < 20; ++i) a.in[i] = (const float*)d_in[i];
    a.out = (float*)d_out; a.ws = (unsigned char*)d_ws;
    hipLaunchKernelGGL(mk_fwd, dim3(grid), dim3(NWAVES * 64), LDS_BYTES, stream, a);
}
```

```cpp
#include <hip/hip_runtime.h>
#include <cstdio>
#include <cstdint>
namespace pg8 {
#define PG8_LAS __attribute__((address_space(3)))
typedef unsigned short bf16_t;
typedef short bf16x8 __attribute__((ext_vector_type(8)));
typedef float f32x4 __attribute__((ext_vector_type(4)));
typedef unsigned u32x4 __attribute__((ext_vector_type(4)));
constexpr int BM = 256, BK = 64, HALF = 128, HTB = HALF * BK * 2  , STAGE_BYTES = 8 * HTB, NXCD = 8, WGM = 8;

__host__ __device__ __forceinline__ int lds_byte(int r, int c) { const int st = (r >> 4) * 2 + (c >> 5), rr = r & 15, cc = c & 31, ob = rr * 64 + cc * 2; return st * 1024 + (ob ^ (((ob >> 9) & 1) << 5)); }
__host__ __device__ __forceinline__ void stage_rc(int b, int& R, int& C) { const int st = b / 1024, sb = b % 1024, swz = sb ^ (((sb >> 9) & 1) << 5); R = (st >> 1) * 16 + swz / 64; C = (st & 1) * 32 + (swz % 64) / 2; }
__host__ __device__ __forceinline__ int perm32(int rho) { const int n = rho >> 4, i = rho & 15; return 8 * (i >> 2) + 4 * n + (i & 3); }

struct Unit { int pm, pn; };
struct Gemm { const bf16_t* A; const bf16_t* Bt; int M, N, K; };

struct StaticOrder {
    int nM, nN, nwg, G, c;
    __host__ __device__ void init(int M, int N, int G_, int c_) { nM = M / BM; nN = N / BM; nwg = nM * nN; G = G_; c = c_; }
    __host__ __device__ bool next(int i, Unit& u) const {
        const long L = (long)i * G + c; if (L >= nwg) return false;
        int wgid = (int)L; { const int q = nwg / NXCD, r = nwg % NXCD, xcd = wgid % NXCD, off = wgid / NXCD; wgid = (xcd < r ? xcd * (q + 1) : r * (q + 1) + (xcd - r) * q) + off; }
        const int nig = WGM * nN, gid = wgid / nig, fm = gid * WGM, gsz = (nM - fm) < WGM ? (nM - fm) : WGM;
        u.pm = fm + ((wgid % nig) % gsz); u.pn = (wgid % nig) / gsz; return true;
    }
    __device__ __forceinline__ void a_ready(const Unit&) const {}
    __device__ __forceinline__ void done(const Unit&) const {}
};

typedef __bf16 pg8_bf16x2 __attribute__((ext_vector_type(2)));
typedef float pg8_f2 __attribute__((ext_vector_type(2)));
__device__ __forceinline__ unsigned cvt_pk_bf16(float lo, float hi) { const pg8_f2 v = {lo, hi}; return __builtin_bit_cast(unsigned, __builtin_convertvector(v, pg8_bf16x2)); }
typedef float f32x2 __attribute__((ext_vector_type(2)));
__device__ __forceinline__ f32x2 gelu_pk(f32x2 v) {
    const f32x2 av = __builtin_elementwise_abs(v), d = av * 0.2316418882f + 1.0f;
    f32x2 t; t.x = __builtin_amdgcn_rcpf(d.x); t.y = __builtin_amdgcn_rcpf(d.y);
    f32x2 q = t * 0.5307027145f + (-0.7265760135f); q = q * t + 0.7107068705f; q = q * t + (-0.142248368f); q = q * t + 0.127414796f; q = q * t;
    const f32x2 s = (v * v) * (-0.72134752044f);
    f32x2 e; e.x = __builtin_amdgcn_exp2f(s.x); e.y = __builtin_amdgcn_exp2f(s.y);
    const f32x2 m = v * (q * e), r = v - m;
    f32x2 o; o.x = v.x < 0.f ? m.x : r.x; o.y = v.y < 0.f ? m.y : r.y; return o;
}

template <int ACT  > struct EpiBf16 {
    static constexpr bool PERM = true, AFTER_DRAIN = false; static_assert(ACT == 0 || ACT == 1, "EpiBf16: ACT is 0 (none) or 1 (gelu_pk)");
    bf16_t* O; int ldc; const float* bias; int split_cols; size_t split_stride; float scale0;
    __device__ __forceinline__ void operator()(const f32x4 (&acc)[2][2][4][2], const Unit& u, int wr, int wc, int fr, int fq) const {
        const int row0 = u.pm * BM + wr * 64 + fr; int colt = u.pn * BM; bf16_t* base = O;
        float sc = 1.f; if (split_cols) { const int t = colt / split_cols; base += (size_t)t * split_stride; colt -= t * split_cols; if (t == 0) sc = scale0; }
        const int col0 = colt + wc * 32 + 8 * fq, bcol0 = u.pn * BM + wc * 32 + 8 * fq;
        f32x4 bv[2][2];
#pragma unroll
        for (int bj = 0; bj < 2; ++bj)
#pragma unroll
            for (int n = 0; n < 2; ++n) bv[bj][n] = bias ? *(const f32x4*)(bias + bcol0 + bj * HALF + 4 * n) : (f32x4){0.f, 0.f, 0.f, 0.f};
#pragma unroll
        for (int ai = 0; ai < 2; ++ai)
#pragma unroll
            for (int m = 0; m < 4; ++m) { bf16_t* rowp = base + (size_t)(row0 + ai * HALF + m * 16) * ldc + col0;
#pragma unroll
                for (int bj = 0; bj < 2; ++bj) { f32x4 v0 = acc[ai][bj][m][0] + bv[bj][0], v1 = acc[ai][bj][m][1] + bv[bj][1];
                    if (ACT == 1) { f32x2 a = gelu_pk((f32x2){v0[0], v0[1]}), b = gelu_pk((f32x2){v0[2], v0[3]}), c = gelu_pk((f32x2){v1[0], v1[1]}), d = gelu_pk((f32x2){v1[2], v1[3]});
                        v0 = (f32x4){a.x, a.y, b.x, b.y}; v1 = (f32x4){c.x, c.y, d.x, d.y}; }
                    v0 = v0 * sc; v1 = v1 * sc; u32x4 w; w.x = cvt_pk_bf16(v0[0], v0[1]); w.y = cvt_pk_bf16(v0[2], v0[3]); w.z = cvt_pk_bf16(v1[0], v1[1]); w.w = cvt_pk_bf16(v1[2], v1[3]);
                    *(u32x4*)(rowp + bj * HALF) = w; } }
    }
};

template <class Epi, class Sched, bool ALIGN_EPI = false, bool SP2 = false>
__device__ __forceinline__ void gemm_phase(PG8_LAS unsigned char* lds, const Gemm g, const Sched& S, const Epi& E) {
    const int tid = threadIdx.x, wid = __builtin_amdgcn_readfirstlane(tid >> 6), lane = tid & 63, wr = wid >> 2, wc = wid & 3, fr = lane & 15, fq = lane >> 4;
    const int K = g.K, nt = K / BK;
    unsigned voffA[2], voffB[2];
#pragma unroll
    for (int i = 0; i < 2; ++i) { int R, C; stage_rc(tid * 16 + i * 8192, R, C); const int Rb = Epi::PERM ? ((R & ~31) + perm32(R & 31)) : R;
        voffA[i] = (unsigned)(R * K + C) * 2u; voffB[i] = (unsigned)(Rb * K + C) * 2u; }
    const size_t kstep = (size_t)(BK * 2);
    const size_t hstep = (size_t)HALF * K * 2;
    const size_t tstep = 2 * hstep;
    const unsigned ldsw = (unsigned)wid * 1024u;
    const int aoff = lds_byte(wr * 64 + fr, fq * 8), boff = lds_byte(wc * 32 + fr, fq * 8);
#define PG8_SA(b, h) (((b) * 2 + (h)) * HTB)
#define PG8_SB(b, h) ((4 + (b) * 2 + (h)) * HTB)
#define PG8_STAGE(bufoff, gbase, voff) do { _Pragma("unroll") for (int _i = 0; _i < 2; ++_i) \
        __builtin_amdgcn_global_load_lds((const unsigned*)((const char*)(gbase) + (voff)[_i]), (PG8_LAS unsigned*)(lds + (bufoff) + ldsw + _i * 8192), 16, 0, 0); } while (0)
#define PG8_LDA(dst, b, h) do { _Pragma("unroll") for (int m = 0; m < 4; ++m) _Pragma("unroll") for (int k = 0; k < 2; ++k) dst[m][k] = *(const PG8_LAS bf16x8*)(lds + PG8_SA(b, h) + aoff + m * 2048 + k * 1024); } while (0)
#define PG8_LDB(dst, b, h) do { _Pragma("unroll") for (int n = 0; n < 2; ++n) _Pragma("unroll") for (int k = 0; k < 2; ++k) dst[n][k] = *(const PG8_LAS bf16x8*)(lds + PG8_SB(b, h) + boff + n * 2048 + k * 1024); } while (0)
#define PG8_MMA(ai, bj, At, Bt) do { __builtin_amdgcn_s_setprio(1); _Pragma("unroll") for (int m = 0; m < 4; ++m) _Pragma("unroll") for (int n = 0; n < 2; ++n) _Pragma("unroll") for (int k = 0; k < 2; ++k) \
        acc[ai][bj][m][n] = __builtin_amdgcn_mfma_f32_16x16x32_bf16(Bt[n][k], At[m][k], acc[ai][bj][m][n], 0, 0, 0); __builtin_amdgcn_s_setprio(0); } while (0)
#define PG8_WAIT_V(n) asm volatile("s_waitcnt vmcnt(" #n ")" ::: "memory")
#define PG8_WAIT_L(n) asm volatile("s_waitcnt lgkmcnt(" #n ")" ::: "memory")
#define PG8_BAR __builtin_amdgcn_s_barrier()
#define PG8_SCHED __builtin_amdgcn_sched_barrier(0)
    Unit cur, nxt; int ui = 0;
    if (!S.next(0, cur)) return;
    f32x4 acc[2][2][4][2];
#pragma unroll
    for (int a = 0; a < 2; ++a)
#pragma unroll
        for (int b = 0; b < 2; ++b)
#pragma unroll
            for (int m = 0; m < 4; ++m)
#pragma unroll
                for (int n = 0; n < 2; ++n) acc[a][b][m][n] = (f32x4){0.f, 0.f, 0.f, 0.f};
    bf16x8 At[4][2], B0[2][2], B1[2][2];
    const char* cA = (const char*)g.A + (size_t)cur.pm * tstep; const char* cB = (const char*)g.Bt + (size_t)cur.pn * tstep;
    S.a_ready(cur);
    if constexpr (SP2) {
        PG8_STAGE(PG8_SB(0, 0), cB, voffB); PG8_STAGE(PG8_SB(0, 1), cB + hstep, voffB); PG8_STAGE(PG8_SA(0, 0), cA, voffA); PG8_STAGE(PG8_SA(0, 1), cA + hstep, voffA);
        if (wr == 1) PG8_BAR;
        PG8_WAIT_V(2); PG8_BAR;
        PG8_STAGE(PG8_SB(1, 0), cB + kstep, voffB); PG8_STAGE(PG8_SA(1, 0), cA + kstep, voffA); PG8_STAGE(PG8_SB(1, 1), cB + hstep + kstep, voffB);
        PG8_WAIT_V(6); PG8_BAR;
    } else {
        PG8_STAGE(PG8_SB(0, 0), cB, voffB); PG8_STAGE(PG8_SA(0, 0), cA, voffA); PG8_STAGE(PG8_SB(0, 1), cB + hstep, voffB); PG8_STAGE(PG8_SA(0, 1), cA + hstep, voffA);
        if (wr == 1) PG8_BAR;
        PG8_WAIT_V(4); PG8_BAR;
        PG8_STAGE(PG8_SB(1, 0), cB + kstep, voffB); PG8_STAGE(PG8_SA(1, 0), cA + kstep, voffA); PG8_STAGE(PG8_SB(1, 1), cB + hstep + kstep, voffB);
        PG8_WAIT_V(6); PG8_BAR;
    }
    for (;;) {
        const bool has_next = S.next(ui + 1, nxt);
        const char* nA = has_next ? (const char*)g.A + (size_t)nxt.pm * tstep : cA; const char* nB = has_next ? (const char*)g.Bt + (size_t)nxt.pn * tstep : cB;
        for (int t = 0; t < nt; t += 2) {
            const bool last = (t == nt - 2);
            const char* a1 = cA + (size_t)(t + 1) * kstep;
            const char* a2 = last ? nA : cA + (size_t)(t + 2) * kstep; const char* b2 = last ? nB : cB + (size_t)(t + 2) * kstep;
            const char* a3 = a2 + kstep; const char* b3 = b2 + kstep;
            if (last && has_next) S.a_ready(nxt);
            if constexpr (SP2) {
            PG8_LDB(B0, 0, 0); PG8_LDB(B1, 0, 1); PG8_SCHED; PG8_LDA(At, 0, 0); PG8_STAGE(PG8_SA(1, 1), a1 + hstep, voffA);
            PG8_WAIT_V(8); PG8_WAIT_L(0); PG8_BAR; PG8_MMA(0, 0, At, B0); PG8_MMA(0, 1, At, B1); PG8_BAR; PG8_SCHED;
            PG8_LDA(At, 0, 1); PG8_STAGE(PG8_SB(0, 0), b2, voffB); PG8_STAGE(PG8_SB(0, 1), b2 + hstep, voffB); PG8_STAGE(PG8_SA(0, 0), a2, voffA);
            PG8_WAIT_V(8); PG8_WAIT_L(0); PG8_BAR; PG8_MMA(1, 0, At, B0); PG8_MMA(1, 1, At, B1); PG8_BAR; PG8_SCHED;
            PG8_LDB(B0, 1, 0); PG8_LDB(B1, 1, 1); PG8_SCHED; PG8_LDA(At, 1, 0); PG8_STAGE(PG8_SA(0, 1), a2 + hstep, voffA);
            PG8_WAIT_V(8); PG8_WAIT_L(0); PG8_BAR; PG8_MMA(0, 0, At, B0); PG8_MMA(0, 1, At, B1); PG8_BAR; PG8_SCHED;
            PG8_LDA(At, 1, 1); PG8_STAGE(PG8_SB(1, 0), b3, voffB); PG8_STAGE(PG8_SB(1, 1), b3 + hstep, voffB); PG8_STAGE(PG8_SA(1, 0), a3, voffA);
            PG8_WAIT_V(8); PG8_WAIT_L(0); PG8_BAR; PG8_MMA(1, 0, At, B0); PG8_MMA(1, 1, At, B1); PG8_BAR; PG8_SCHED;
            } else {
            PG8_LDB(B0, 0, 0); PG8_SCHED; PG8_LDA(At, 0, 0); PG8_STAGE(PG8_SA(1, 1), a1 + hstep, voffA);
            PG8_WAIT_L(8); PG8_BAR; PG8_WAIT_L(0); PG8_MMA(0, 0, At, B0); PG8_BAR; PG8_SCHED;
            PG8_LDB(B1, 0, 1); PG8_STAGE(PG8_SB(0, 0), b2, voffB);
            PG8_BAR; PG8_WAIT_L(0); PG8_MMA(0, 1, At, B1); PG8_BAR;
            PG8_LDA(At, 0, 1); PG8_STAGE(PG8_SA(0, 0), a2, voffA);
            PG8_BAR; PG8_WAIT_L(0); PG8_MMA(1, 0, At, B0); PG8_BAR; PG8_SCHED;
            PG8_STAGE(PG8_SB(0, 1), b2 + hstep, voffB);
            PG8_WAIT_V(6); PG8_BAR; PG8_MMA(1, 1, At, B1); PG8_BAR;
            PG8_LDB(B0, 1, 0); PG8_SCHED; PG8_LDA(At, 1, 0); PG8_STAGE(PG8_SA(0, 1), a2 + hstep, voffA);
            PG8_WAIT_L(8); PG8_BAR; PG8_WAIT_L(0); PG8_MMA(0, 0, At, B0); PG8_BAR; PG8_SCHED;
            PG8_LDB(B1, 1, 1); PG8_STAGE(PG8_SB(1, 0), b3, voffB);
            PG8_BAR; PG8_WAIT_L(0); PG8_MMA(0, 1, At, B1); PG8_BAR;
            PG8_LDA(At, 1, 1); PG8_STAGE(PG8_SA(1, 0), a3, voffA);
            PG8_BAR; PG8_WAIT_L(0); PG8_MMA(1, 0, At, B0); PG8_BAR; PG8_SCHED;
            PG8_STAGE(PG8_SB(1, 1), b3 + hstep, voffB);
            PG8_WAIT_V(6); PG8_BAR; PG8_MMA(1, 1, At, B1); PG8_BAR;
            }
        }
        if constexpr (ALIGN_EPI) { if (wr == 0) PG8_BAR; }
        if constexpr (!Epi::AFTER_DRAIN) { E(acc, cur, wr, wc, fr, fq); S.done(cur); }
        if (!has_next) break;
#pragma unroll
        for (int a = 0; a < 2; ++a)
#pragma unroll
            for (int b = 0; b < 2; ++b)
#pragma unroll
                for (int m = 0; m < 4; ++m)
#pragma unroll
                    for (int n = 0; n < 2; ++n) acc[a][b][m][n] = (f32x4){0.f, 0.f, 0.f, 0.f};
        cur = nxt; cA = nA; cB = nB; ++ui;
        if constexpr (ALIGN_EPI) { if (wr == 1) PG8_BAR; }
    }
    PG8_WAIT_V(0);
    if constexpr (!ALIGN_EPI) { if (wr == 0) PG8_BAR; }
    PG8_BAR;
    if constexpr (Epi::AFTER_DRAIN) { E.fused(acc, cur, wr, wc, fr, fq, lds, wid, lane); S.done(cur); }
#undef PG8_SA
#undef PG8_SB
#undef PG8_STAGE
#undef PG8_LDA
#undef PG8_LDB
#undef PG8_MMA
#undef PG8_WAIT_V
#undef PG8_WAIT_L
#undef PG8_BAR
#undef PG8_SCHED
}
}
#define PG8_SP2 true
#define PG8_ALIGN true
constexpr int NWAVES = 8;
constexpr int BATCH = 8, SEQ = 2048, DM = 1024, CTXL = 256, NTOK = BATCH * SEQ, NCTX = BATCH * CTXL, NROWS = NTOK + NCTX;
constexpr int C_ALR = 1536, C_BQ = 1568, C_BG = 3104, C_BBETA = 3616, C_MG = 3632, D_IN = 5680;
constexpr int NIN = 5888;
constexpr int NSM = 48;
constexpr float EPSV = 1e-6f;
constexpr size_t MiB = 1u << 20;
constexpr size_t WS_CTL = 0, CTL_ZERO_BYTES = 1 * MiB;
constexpr int CW_BAR = 4096;
constexpr size_t WS_MOD = 64 * 1024, WS_ROWSS = 256 * 1024;
constexpr size_t WS_WTIN = 2 * MiB, WS_WTGA = 14 * MiB, WS_WTGD = 15 * MiB, WS_WTO = 16 * MiB;
constexpr size_t WS_H = 18 * MiB, WS_AQ = 54 * MiB, WS_AK = 62 * MiB, WS_PRE = 71 * MiB, WS_SM = 125 * MiB, WS_VTA = 129 * MiB;
constexpr size_t WS_KIMG = 147 * MiB, WS_KTIMG = 165 * MiB, WS_VT = 183 * MiB, WS_TBIMG = 201 * MiB, WS_KDTIMG = 219 * MiB, WS_SCAL = 237 * MiB, WS_EBL = 239 * MiB + 512 * 1024;
constexpr size_t DO_QIMG = 0, DO_AQKIMG = 16 * MiB, DO_QEIMG = 32 * MiB, DO_ATTIMG = 48 * MiB;
#ifndef DBG_NAIVE_GDN
#define DBG_NAIVE_GDN 0
#endif
#ifndef DBG_NAIVE_GLA
#define DBG_NAIVE_GLA 0
#endif
#if DBG_NAIVE_GLA
constexpr size_t WS_OAF = 219 * MiB, WS_OAB = 240 * MiB;
#else
constexpr size_t WS_OAF = 54 * MiB, WS_OAB = 70 * MiB;
#endif
constexpr size_t WS_OBF = 86 * MiB, WS_OBB = 102 * MiB, WS_AG = 118 * MiB, WS_BG = 134 * MiB, WS_YA = 150 * MiB, WS_YB = 166 * MiB;
constexpr size_t WS_TMP = 182 * MiB, WS_MERGED = 18 * MiB, WS_END = 256 * MiB;
constexpr size_t WS_POST = WS_KIMG, DO_DBGAV = 32 * MiB;
constexpr int LDS_BYTES = 147456 + 256;
constexpr int MISC_OFF = 147456;

#define GAS __attribute__((address_space(1)))
#define LAS __attribute__((address_space(3)))
typedef unsigned short bf16;
typedef unsigned v4u __attribute__((ext_vector_type(4)));
typedef unsigned v2u __attribute__((ext_vector_type(2)));
typedef float f32x4 __attribute__((ext_vector_type(4)));
#define LDS_WAIT() asm volatile("s_waitcnt lgkmcnt(0)" ::: "memory")
#define VM_WAIT() asm volatile("s_waitcnt vmcnt(0)" ::: "memory")
__device__ __forceinline__ unsigned f2bf(float f) { unsigned u = __builtin_bit_cast(unsigned, f); return (u + 0x7fffu + ((u >> 16) & 1u)) >> 16; }
__device__ __forceinline__ unsigned pk2(float lo, float hi) { return f2bf(lo) | (f2bf(hi) << 16); }
__device__ __forceinline__ float bflo(unsigned w) { return __builtin_bit_cast(float, w << 16); }
__device__ __forceinline__ float bfhi(unsigned w) { return __builtin_bit_cast(float, w & 0xffff0000u); }
__device__ __forceinline__ float bf2f(bf16 b) { return __builtin_bit_cast(float, ((unsigned)b) << 16); }
__device__ __forceinline__ float fsigm(float x) { return __builtin_amdgcn_rcpf(1.f + __expf(-x)); }
__device__ __forceinline__ float fsilu(float x) { return x * fsigm(x); }
__device__ __forceinline__ float softplusf_(float x) { return fmaxf(x, 0.f) + log1pf(expf(-fabsf(x))); }
__device__ __forceinline__ float logsigf_(float x) { return fminf(x, 0.f) - log1pf(expf(-fabsf(x))); }
__device__ __forceinline__ void unpack8(v4u w, float (&v)[8]) { v[0] = bflo(w.x); v[1] = bfhi(w.x); v[2] = bflo(w.y); v[3] = bfhi(w.y); v[4] = bflo(w.z); v[5] = bfhi(w.z); v[6] = bflo(w.w); v[7] = bfhi(w.w); }
__device__ __forceinline__ v4u pack8(const float (&v)[8]) { v4u w; w.x = pk2(v[0], v[1]); w.y = pk2(v[2], v[3]); w.z = pk2(v[4], v[5]); w.w = pk2(v[6], v[7]); return w; }
__device__ __forceinline__ float wave_sum(float v) {
#pragma unroll
    for (int o = 1; o < 64; o <<= 1) v += __shfl_xor(v, o);
    return v;
}
__device__ __forceinline__ float grp16_sum(float v) {
#pragma unroll
    for (int o = 1; o < 16; o <<= 1) v += __shfl_xor(v, o);
    return v;
}

#define XB_TMO      128
#define XB_XCNT(j)  (256  + 64 * (j))
#define XB_XSUB(j)  (1280 + 64 * (j))
#define XB_XGEN(j)  (2304 + 64 * (j))
#define XB_TOP      3328
#define XB_TOPGEN   3392
#define XCD_BAR_WORDS 3456
#define XB_SPIN_CAP (1u << 22)
__device__ __forceinline__ unsigned xb_ld(unsigned* p)              { return __hip_atomic_load(p, __ATOMIC_RELAXED, __HIP_MEMORY_SCOPE_AGENT); }
__device__ __forceinline__ unsigned xb_add(unsigned* p, unsigned v) { return __hip_atomic_fetch_add(p, v, __ATOMIC_RELAXED, __HIP_MEMORY_SCOPE_AGENT); }
__device__ __forceinline__ unsigned xb_xcc_id() { return (unsigned)__builtin_amdgcn_s_getreg((3 << 11) | 20) & 0xFu; }
#define XB_SPIN(cond, bar) do { unsigned _sp = 0; while (cond) { __builtin_amdgcn_s_sleep(1); \
    if ((++_sp & 255u) == 0u) { if (xb_ld(&(bar)[XB_TMO])) break; if (_sp > XB_SPIN_CAP) { atomicAdd(&(bar)[XB_TMO], 1u); break; } } } } while (0)
struct XcdBarrier { unsigned* bar; unsigned x; volatile LAS unsigned* st; };
__device__ __forceinline__ XcdBarrier xcd_barrier_post(unsigned* bar, volatile LAS unsigned* st) {
    XcdBarrier b; b.bar = bar; b.x = xb_xcc_id(); b.st = st;
    if (threadIdx.x == 0) (void)xb_add(&bar[XB_XCNT(b.x)], 1u);
    return b;
}
__device__ __forceinline__ void xcd_barrier_complete(unsigned* bar, unsigned x, unsigned& nloc, unsigned& nx) {
    const unsigned G = gridDim.x * gridDim.y * gridDim.z;
    unsigned sum, cnt, mine, sp = 0u;
    for (;;) {
        sum = 0u; cnt = 0u; mine = 0u;
#pragma unroll
        for (unsigned j = 0; j < 16; ++j) { const unsigned c = xb_ld(&bar[XB_XCNT(j)]); sum += c; cnt += (c > 0u) ? 1u : 0u; mine = (j == x) ? c : mine; }
        if (sum == G) break;
        __builtin_amdgcn_s_sleep(1);
        if ((++sp & 255u) == 0u) { if (xb_ld(&bar[XB_TMO])) break; if (sp > XB_SPIN_CAP) { atomicAdd(&bar[XB_TMO], 1u); break; } }
    }
    nloc = mine > 0u ? mine : 1u; nx = cnt > 0u ? cnt : 1u;
}
__device__ __forceinline__ void xcd_barrier(const XcdBarrier& b) {
    asm volatile("s_waitcnt vmcnt(0)" ::: "memory");
    __syncthreads();
    if (threadIdx.x == 0) {
        unsigned* bar = b.bar;
        __builtin_amdgcn_s_waitcnt(0);
        unsigned nloc = b.st[0], nx = b.st[1];
        if (nloc == 0u) { xcd_barrier_complete(bar, b.x, nloc, nx); b.st[0] = nloc; b.st[1] = nx; }
        const unsigned old = xb_add(&bar[XB_XSUB(b.x)], 1u);
        const unsigned gen = old / nloc;
        if (old + 1u == (gen + 1u) * nloc) {
            __builtin_amdgcn_fence(__ATOMIC_RELEASE, "agent");
            asm volatile("s_waitcnt vmcnt(0)" ::: "memory");
            const unsigned og = xb_add(&bar[XB_TOP], 1u);
            const unsigned tg = og / nx;
            if (og + 1u == (tg + 1u) * nx) xb_add(&bar[XB_TOPGEN], 1u);
            else XB_SPIN(xb_ld(&bar[XB_TOPGEN]) == tg, bar);
            __builtin_amdgcn_fence(__ATOMIC_ACQUIRE, "agent");
            xb_add(&bar[XB_XGEN(b.x)], 1u);
            asm volatile("s_waitcnt vmcnt(0)" ::: "memory");
        } else {
            XB_SPIN(xb_ld(&bar[XB_XGEN(b.x)]) == gen, bar);
            __builtin_amdgcn_fence(__ATOMIC_ACQUIRE, "agent");
            asm volatile("s_waitcnt vmcnt(0)" ::: "memory");
        }
    }
    __syncthreads();
}

namespace pg8 {
struct EpiIn {
    static constexpr bool PERM = true, AFTER_DRAIN = false;
    unsigned char* ws; bf16* GATES; float* SM; const float* b_gate; int pnoff;
    __device__ __forceinline__ void operator()(const f32x4 (&acc)[2][2][4][2], const Unit& u, int wr, int wc, int fr, int fq) const {
        const int pn = u.pn + pnoff, row0 = u.pm * BM + wr * 64 + fr; const bool lat = u.pm < NTOK / BM;
        if (pn == 10) {
            if (wc > 1 || (wc == 1 && fq >= 2)) return;
            const int c0 = wc * 32 + 8 * fq;
#pragma unroll
            for (int ai = 0; ai < 2; ++ai)
#pragma unroll
                for (int m = 0; m < 4; ++m) { float* rp = SM + (size_t)(row0 + ai * HALF + m * 16) * NSM + c0;
                    *(f32x4*)rp = acc[ai][0][m][0]; *(f32x4*)(rp + 4) = acc[ai][0][m][1]; }
            return;
        }
        if (pn == 2 || pn == 3) {
            bf16* VTA = (bf16*)(ws + WS_VTA);
#if DBG_NAIVE_GLA
            bf16* AVR = GATES + DO_DBGAV / 2;
#endif
#pragma unroll
            for (int ai = 0; ai < 2; ++ai)
#pragma unroll
                for (int m = 0; m < 4; ++m) { const int row = row0 + ai * HALF + m * 16; int b, cid;
                    if (row < NTOK) { b = row >> 11; cid = 4 + ((row & 2047) >> 6); } else { const int rr = row - NTOK; b = rr >> 8; cid = (rr & 255) >> 6; }
                    const int pos = row & 63;
#pragma unroll
                    for (int bj = 0; bj < 2; ++bj) { const int h = (pn - 2) * 2 + bj; bf16* dst = VTA + ((size_t)((b * 4 + h) * 36 + cid) * 128 + wc * 32 + 8 * fq) * 64 + pos;
#pragma unroll
                        for (int n = 0; n < 2; ++n)
#pragma unroll
                            for (int j = 0; j < 4; ++j) dst[(4 * n + j) * 64] = (bf16)(cvt_pk_bf16(acc[ai][bj][m][n][j], 0.f) & 0xffffu);
#if DBG_NAIVE_GLA
                        u32x4 w; w.x = cvt_pk_bf16(acc[ai][bj][m][0][0], acc[ai][bj][m][0][1]); w.y = cvt_pk_bf16(acc[ai][bj][m][0][2], acc[ai][bj][m][0][3]); w.z = cvt_pk_bf16(acc[ai][bj][m][1][0], acc[ai][bj][m][1][1]); w.w = cvt_pk_bf16(acc[ai][bj][m][1][2], acc[ai][bj][m][1][3]);
                        *(u32x4*)(AVR + (size_t)row * 512 + (pn - 2) * 256 + bj * HALF + wc * 32 + 8 * fq) = w;
#endif
                    } }
            return;
        }
        size_t boff; int ld, cb, act = 0; float sc = 1.f; bool latonly = false;
        if (pn == 0) { boff = WS_AQ; ld = 256; cb = 0; sc = 0.125f; latonly = true; }
        else if (pn == 1) { boff = WS_AK; ld = 256; cb = 0; }
        else if (pn < 10) { boff = WS_PRE; ld = 1536; cb = (pn - 4) * 256; }
        else if (pn < 13) { boff = WS_AG; ld = 512; cb = (pn - 11) * 256; act = 1; latonly = true; }
        else if (pn < 15) { boff = WS_BG; ld = 512; cb = (pn - 13) * 256; act = 1; latonly = true; }
        else { boff = 0; ld = 2048; cb = (pn - 15) * 256; act = 2; latonly = true; }
        bf16* base = (pn >= 15) ? GATES : (bf16*)(ws + boff);
        if (latonly && !lat) return;
        const int col0 = cb + wc * 32 + 8 * fq;
#pragma unroll
        for (int ai = 0; ai < 2; ++ai)
#pragma unroll
            for (int m = 0; m < 4; ++m) { bf16* rowp = base + (size_t)(row0 + ai * HALF + m * 16) * ld + col0;
#pragma unroll
                for (int bj = 0; bj < 2; ++bj) { f32x4 v0 = acc[ai][bj][m][0], v1 = acc[ai][bj][m][1];
                    if (act == 1) {
#pragma unroll
                        for (int j = 0; j < 4; ++j) { v0[j] = fsilu(v0[j]); v1[j] = fsilu(v1[j]); } }
                    else if (act == 2) { const f32x4 b0 = *(const f32x4*)(b_gate + col0 + bj * HALF), b1 = *(const f32x4*)(b_gate + col0 + bj * HALF + 4);
#pragma unroll
                        for (int j = 0; j < 4; ++j) { v0[j] = fsigm(v0[j] + b0[j]); v1[j] = fsigm(v1[j] + b1[j]); } }
                    else { v0 = v0 * sc; v1 = v1 * sc; }
                    u32x4 w; w.x = cvt_pk_bf16(v0[0], v0[1]); w.y = cvt_pk_bf16(v0[2], v0[3]); w.z = cvt_pk_bf16(v1[0], v1[1]); w.w = cvt_pk_bf16(v1[2], v1[3]);
                    *(u32x4*)(rowp + bj * HALF) = w; } }
    }
};
struct OrderA {
    int G, c;
    __device__ void init(int G_, int c_) { G = G_; c = c_; }
    __device__ bool next(int i, Unit& u) const {
        const int L = i * G + c; if (L >= 768) return false;
        if (L < 704) { int wgid = L; { const int q = 704 / NXCD, xcd = wgid % NXCD, off = wgid / NXCD; wgid = xcd * q + off; }
            const int nN = 11, nM = 64, nig = WGM * nN, gid = wgid / nig, fm = gid * WGM, gsz = (nM - fm) < WGM ? (nM - fm) : WGM;
            u.pm = fm + ((wgid % nig) % gsz); u.pn = (wgid % nig) / gsz; return true; }
        const int l2 = L - 704, idx = l2 >> 3; u.pm = 64 + (l2 & 7); u.pn = idx < 3 ? idx + 1 : idx + 3; return true;
    }
    __device__ __forceinline__ void a_ready(const Unit&) const {}
    __device__ __forceinline__ void done(const Unit&) const {}
};
struct EpiGa {
    static constexpr bool PERM = true, AFTER_DRAIN = false;
    const bf16* GATES; float* TMP;
    __device__ __forceinline__ void operator()(const f32x4 (&acc)[2][2][4][2], const Unit& u, int wr, int wc, int fr, int fq) const {
        const int row0 = u.pm * BM + wr * 64 + fr, col0 = u.pn * BM + wc * 32 + 8 * fq;
#pragma unroll
        for (int ai = 0; ai < 2; ++ai)
#pragma unroll
            for (int m = 0; m < 4; ++m) { const size_t r = (size_t)(row0 + ai * HALF + m * 16);
#pragma unroll
                for (int bj = 0; bj < 2; ++bj) { const u32x4 g = *(const u32x4*)(GATES + r * 2048 + col0 + bj * HALF); float gv[8]; unpack8((v4u)g, gv);
                    f32x4 v0 = acc[ai][bj][m][0], v1 = acc[ai][bj][m][1];
#pragma unroll
                    for (int j = 0; j < 4; ++j) { v0[j] *= gv[j]; v1[j] *= gv[4 + j]; }
                    float* tp = TMP + r * 1024 + col0 + bj * HALF; *(f32x4*)tp = v0; *(f32x4*)(tp + 4) = v1; } }
    }
};
struct EpiGb {
    static constexpr bool PERM = true, AFTER_DRAIN = false;
    const bf16* GATES; const float* TMP; bf16* MERGED;
    __device__ __forceinline__ void operator()(const f32x4 (&acc)[2][2][4][2], const Unit& u, int wr, int wc, int fr, int fq) const {
        const int row0 = u.pm * BM + wr * 64 + fr, col0 = u.pn * BM + wc * 32 + 8 * fq;
#pragma unroll
        for (int ai = 0; ai < 2; ++ai)
#pragma unroll
            for (int m = 0; m < 4; ++m) { const size_t r = (size_t)(row0 + ai * HALF + m * 16);
#pragma unroll
                for (int bj = 0; bj < 2; ++bj) { const u32x4 g = *(const u32x4*)(GATES + r * 2048 + 1024 + col0 + bj * HALF); float gv[8]; unpack8((v4u)g, gv);
                    const float* tp = TMP + r * 1024 + col0 + bj * HALF; f32x4 v0 = *(const f32x4*)tp, v1 = *(const f32x4*)(tp + 4);
#pragma unroll
                    for (int j = 0; j < 4; ++j) { v0[j] += gv[j] * acc[ai][bj][m][0][j]; v1[j] += gv[4 + j] * acc[ai][bj][m][1][j]; }
                    u32x4 w; w.x = cvt_pk_bf16(v0[0], v0[1]); w.y = cvt_pk_bf16(v0[2], v0[3]); w.z = cvt_pk_bf16(v1[0], v1[1]); w.w = cvt_pk_bf16(v1[2], v1[3]);
                    *(u32x4*)(MERGED + r * 1024 + col0 + bj * HALF) = w; } }
    }
};
struct EpiOut {
    static constexpr bool PERM = true, AFTER_DRAIN = false;
    const float* x; const float* MOD; float* out; float* ROWSS;
    __device__ __forceinline__ void operator()(const f32x4 (&acc)[2][2][4][2], const Unit& u, int wr, int wc, int fr, int fq) const {
        const int row0 = u.pm * BM + wr * 64 + fr, col0 = u.pn * BM + wc * 32 + 8 * fq;
        const float* gt = MOD + (size_t)(u.pm * BM / SEQ) * 3072 + 2048 + col0;
        f32x4 g[2][2];
#pragma unroll
        for (int bj = 0; bj < 2; ++bj) { g[bj][0] = *(const f32x4*)(gt + bj * HALF); g[bj][1] = *(const f32x4*)(gt + bj * HALF + 4); }
#pragma unroll
        for (int ai = 0; ai < 2; ++ai)
#pragma unroll
            for (int m = 0; m < 4; ++m) { const size_t r = (size_t)(row0 + ai * HALF + m * 16); float ss = 0.f;
#pragma unroll
                for (int bj = 0; bj < 2; ++bj) { const float* xp = x + r * 1024 + col0 + bj * HALF; float* op = out + r * 1024 + col0 + bj * HALF;
                    f32x4 y0 = *(const f32x4*)xp + g[bj][0] * acc[ai][bj][m][0], y1 = *(const f32x4*)(xp + 4) + g[bj][1] * acc[ai][bj][m][1];
                    *(f32x4*)op = y0; *(f32x4*)(op + 4) = y1;
                    ss += (y0[0] * y0[0] + y0[1] * y0[1]) + (y0[2] * y0[2] + y0[3] * y0[3]) + (y1[0] * y1[0] + y1[1] * y1[1]) + (y1[2] * y1[2] + y1[3] * y1[3]); }
                ss += __shfl_xor(ss, 16); ss += __shfl_xor(ss, 32);
                if (fq == 0) atomicAdd(ROWSS + r, ss); }
    }
};
}

struct Args { const float* in[20]; float* out; unsigned char* ws; };
struct Frame {
    LAS unsigned char* lds; volatile LAS unsigned* MISC; unsigned* ctl;
    int tid, lane, wave, vcu, G, gw, NGW;
    const float *x, *c, *ctx, *c_ctx, *w_mod, *b_mod, *norm_g, *w_in, *gla_up, *gla_ub, *gla_onorm, *gdn_conv, *gdn_a_log, *gdn_dt_bias, *gdn_onorm, *w_gla_out, *w_gdn_out, *b_gate, *w_o, *final_g;
    float* out; unsigned char* ws;
};

__device__ __forceinline__ int in_src_col(int d) {
    if (d < 1024) return d;
    if (d < 2560) return C_BQ + (d - 1024);
    if (d < 2592) return C_ALR + (d - 2560);
    if (d < 2608) return C_BBETA + (d - 2592);
    if (d < 2816) return -1;
    if (d < 3328) return 1024 + (d - 2816);
    if (d < 3840) return C_BG + (d - 3328);
    return C_MG + (d - 3840);
}
template <bool MAP>
__device__ __forceinline__ void p0_transpose_item(const float* W, int K, int ldw, int nblk, bf16* WT, LAS float* scr, int item, int lane) {
    const int kb = item / nblk, nb = item % nblk, k0 = 64 * kb, n0 = 32 * nb;
    const int sc = MAP ? in_src_col(n0 + (lane & 31)) : n0 + (lane & 31);
#pragma unroll 8
    for (int i = 0; i < 32; ++i) { const int kk = 2 * i + (lane >> 5); scr[kk * 33 + (lane & 31)] = sc >= 0 ? W[(size_t)(k0 + kk) * ldw + sc] : 0.f; }
    LDS_WAIT(); asm volatile("" ::: "memory");
    const int c = lane & 7;
#pragma unroll
    for (int j = 0; j < 4; ++j) { const int n = (lane >> 3) + 8 * j; const LAS float* s = scr + (8 * c) * 33 + n;
        v4u o; o.x = pk2(s[0 * 33], s[1 * 33]); o.y = pk2(s[2 * 33], s[3 * 33]); o.z = pk2(s[4 * 33], s[5 * 33]); o.w = pk2(s[6 * 33], s[7 * 33]);
        *(GAS v4u*)(WT + (size_t)(n0 + n) * K + k0 + 8 * c) = o; }
    LDS_WAIT(); asm volatile("" ::: "memory");
}
__device__ __forceinline__ void p0_prologue(Frame& F) {
    LAS float* tab = (LAS float*)(F.lds + 69632);
    for (int i = F.tid; i < 9 * 1024; i += NWAVES * 64) { const int r = i >> 10, k = i & 1023; const float v = r < 8 ? F.c[r * 1024 + k] : F.c_ctx[k]; tab[i] = v / (1.f + __expf(-v)); }
    __syncthreads();
    float* MOD = (float*)(F.ws + WS_MOD);
    for (int it = F.gw; it < 768; it += F.NGW) {
        const int cb = it % 48, ks = it / 48, j = cb * 64 + F.lane; float acc[9];
#pragma unroll
        for (int r = 0; r < 9; ++r) acc[r] = 0.f;
#pragma unroll 8
        for (int kk = 0; kk < 64; ++kk) { const int k = ks * 64 + kk; const float w = F.w_mod[(size_t)k * 3072 + j];
#pragma unroll
            for (int r = 0; r < 9; ++r) acc[r] += tab[r * 1024 + k] * w; }
        const float bias = ks == 0 ? F.b_mod[j] : 0.f;
#pragma unroll
        for (int r = 0; r < 9; ++r) atomicAdd(MOD + r * 3072 + j, acc[r] + bias);
    }
    LAS float* scr = (LAS float*)(F.lds + F.wave * 8704);
    constexpr int I_IN = 16 * (NIN / 32), I_G = 8 * 32, I_O = 16 * 32, NITEMS = I_IN + 2 * I_G + I_O;
    for (int it = F.gw; it < NITEMS; it += F.NGW) {
        int r = it;
        if (r < I_IN) { p0_transpose_item<true>(F.w_in, 1024, D_IN, NIN / 32, (bf16*)(F.ws + WS_WTIN), scr, r, F.lane); continue; } r -= I_IN;
        if (r < I_G) { p0_transpose_item<false>(F.w_gla_out, 512, 1024, 32, (bf16*)(F.ws + WS_WTGA), scr, r, F.lane); continue; } r -= I_G;
        if (r < I_G) { p0_transpose_item<false>(F.w_gdn_out, 512, 1024, 32, (bf16*)(F.ws + WS_WTGD), scr, r, F.lane); continue; } r -= I_G;
        p0_transpose_item<false>(F.w_o, 1024, 1024, 32, (bf16*)(F.ws + WS_WTO), scr, r, F.lane);
    }
}
__device__ __forceinline__ void p1_rows(Frame& F) {
    const float* MOD = (const float*)(F.ws + WS_MOD); bf16* H = (bf16*)(F.ws + WS_H);
    for (int row = F.gw; row < NROWS; row += F.NGW) {
        const float* xr = row < NTOK ? F.x + (size_t)row * DM : F.ctx + (size_t)(row - NTOK) * DM; const int r = row < NTOK ? row / SEQ : BATCH;
        const f32x4* xv = (const f32x4*)xr + F.lane; f32x4 v[4]; float s = 0.f;
#pragma unroll
        for (int j = 0; j < 4; ++j) { v[j] = xv[64 * j]; s += (v[j].x * v[j].x + v[j].y * v[j].y) + (v[j].z * v[j].z + v[j].w * v[j].w); }
        const float rstd = 1.f / sqrtf(wave_sum(s) * (1.f / DM) + EPSV);
        const f32x4* sh = (const f32x4*)(MOD + (size_t)r * 3072) + F.lane; const f32x4* sc = sh + 256; const f32x4* g = (const f32x4*)F.norm_g + F.lane;
        unsigned long long* o8 = (unsigned long long*)(H + (size_t)row * DM) + F.lane;
#pragma unroll
        for (int j = 0; j < 4; ++j) { const f32x4 gg = g[64 * j], cc = sc[64 * j], hh = sh[64 * j]; const f32x4 y = (v[j] * rstd * gg) * (cc + 1.f) + hh;
            o8[64 * j] = (unsigned long long)pk2(y.x, y.y) | ((unsigned long long)pk2(y.z, y.w) << 32); }
    }
}
__device__ __forceinline__ void p3_conv(Frame& F) {
    const bf16* PRE = (const bf16*)(F.ws + WS_PRE); bf16* POST = (bf16*)(F.ws + WS_POST);
    for (int row = F.gw; row < NROWS; row += F.NGW) {
        const bool lat = row < NTOK; int base, t, len;
        if (lat) { base = (row / SEQ) * SEQ; t = row % SEQ; len = SEQ; } else { const int rr = row - NTOK; base = NTOK + (rr / CTXL) * CTXL; t = rr % CTXL; len = CTXL; }
        const int gx = t & 63;
#pragma unroll 1
        for (int wh = 0; wh < 3; ++wh) {
            float acc[8];
#pragma unroll
            for (int e = 0; e < 8; ++e) acc[e] = 0.f;
            const int ch = wh * 512 + 8 * F.lane;
#pragma unroll 1
            for (int dy = (lat ? 0 : 1); dy < (lat ? 3 : 2); ++dy)
#pragma unroll
                for (int dx = 0; dx < 3; ++dx) {
                    int tt; bool ok;
                    if (lat) { const int yy = (t >> 6) + dy - 1, xx = gx + dx - 1; ok = yy >= 0 && yy < SEQ / 64 && xx >= 0 && xx < 64; tt = yy * 64 + xx; }
                    else { tt = t + dx - 1; ok = tt >= 0 && tt < len; }
                    if (!ok) continue;
                    const v4u w = *(const v4u*)(PRE + (size_t)(base + tt) * 1536 + ch); float v[8]; unpack8(w, v);
                    const f32x4* cw = (const f32x4*)(F.gdn_conv + (size_t)(dy * 3 + dx) * 1536 + ch); const f32x4 c0 = cw[0], c1 = cw[1];
#pragma unroll
                    for (int e = 0; e < 4; ++e) { acc[e] += v[e] * c0[e]; acc[4 + e] += v[4 + e] * c1[e]; }
                }
            float ss = 0.f;
#pragma unroll
            for (int e = 0; e < 8; ++e) { acc[e] = fsilu(acc[e]); ss += acc[e] * acc[e]; }
            if (wh < 2) { ss = grp16_sum(ss); float scl = 1.f / sqrtf(ss + EPSV); if (wh == 0) scl *= 0.08838834764831845f;
#pragma unroll
                for (int e = 0; e < 8; ++e) acc[e] *= scl; }
            *(v4u*)(POST + (size_t)row * 1536 + ch) = pack8(acc);
        }
    }
}
__device__ __forceinline__ int scan_row(int b, int dir, int pos, bool& latent) {
    if (pos < CTXL) { latent = false; return NTOK + b * CTXL + (dir ? CTXL - 1 - pos : pos); }
    const int q = pos - CTXL; latent = true; return b * SEQ + (dir ? SEQ - 1 - q : q);
}
__device__ __forceinline__ void p4_scan_naive(Frame& F) {
    const int item = F.vcu; if (item < 128 || F.tid >= 128) return;
    const int e = F.tid, br = item < 192 ? 1 : 0, bid = item & 63, dir = bid & 1, h = (bid >> 1) & 3, b = bid >> 3;
    if (br == 0 ? !DBG_NAIVE_GDN : !DBG_NAIVE_GLA) return;
    const float* SM = (const float*)(F.ws + WS_SM);
    if (br == 0) {
        const bf16* POST = (const bf16*)(F.ws + WS_POST); bf16* O = (bf16*)(F.ws + (dir ? WS_OBB : WS_OBF));
        float S[128];
#pragma unroll
        for (int d = 0; d < 128; ++d) S[d] = 0.f;
        const float A = -expf(F.gdn_a_log[dir * 4 + h]), dtb = F.gdn_dt_bias[dir * 4 + h];
        for (int pos = 0; pos < CTXL + SEQ; ++pos) {
            bool lat; const int row = scan_row(b, dir, pos, lat);
            const v4u* q = (const v4u*)(POST + (size_t)row * 1536 + h * 128); const v4u* k = (const v4u*)(POST + (size_t)row * 1536 + 512 + h * 128);
            const float v = bf2f(POST[(size_t)row * 1536 + 1024 + h * 128 + e]);
            const float beta = 1.f / (1.f + expf(-SM[(size_t)row * NSM + 32 + dir * 4 + h]));
            const float eg = expf(A * softplusf_(SM[(size_t)row * NSM + 40 + dir * 4 + h] + dtb));
            float ks = 0.f;
#pragma unroll
            for (int c = 0; c < 16; ++c) { float kv[8]; unpack8(k[c], kv); if ((c & 3) == 3) asm volatile("" ::: "memory");
#pragma unroll
                for (int j = 0; j < 8; ++j) ks += kv[j] * S[c * 8 + j]; }
            const float vn = beta * (v - eg * ks); float o = 0.f;
#pragma unroll
            for (int c = 0; c < 16; ++c) { float kv[8], qv[8]; unpack8(k[c], kv); unpack8(q[c], qv); if ((c & 1) == 1) asm volatile("" ::: "memory");
#pragma unroll
                for (int j = 0; j < 8; ++j) { S[c * 8 + j] = eg * S[c * 8 + j] + kv[j] * vn; o += qv[j] * S[c * 8 + j]; } }
            if (lat) O[(size_t)row * 512 + h * 128 + e] = (bf16)f2bf(o);
        }
    } else {
        const bf16* AQ = (const bf16*)(F.ws + WS_AQ); const bf16* AK = (const bf16*)(F.ws + WS_AK); const bf16* AV = (const bf16*)((unsigned char*)F.out + DO_DBGAV); bf16* O = (bf16*)(F.ws + (dir ? WS_OAB : WS_OAF));
        float S[64];
#pragma unroll
        for (int d = 0; d < 64; ++d) S[d] = 0.f;
        for (int pos = 0; pos < CTXL + SEQ; ++pos) {
            bool lat; const int row = scan_row(b, dir, pos, lat);
            const float v = bf2f(AV[(size_t)row * 512 + h * 128 + e]);
            float lr[16];
#pragma unroll
            for (int r = 0; r < 16; ++r) lr[r] = SM[(size_t)row * NSM + dir * 16 + r];
            float o = 0.f; int zo = 0; asm volatile("" : "+v"(zo));
#pragma unroll
            for (int d = 0; d < 64; ++d) {
                float u = F.gla_ub[dir * 256 + h * 64 + d + zo];
#pragma unroll
                for (int r = 0; r < 16; ++r) u += lr[r] * F.gla_up[(size_t)(dir * 16 + r) * 256 + h * 64 + d + zo];
                const float dec = expf(logsigf_(u) * (1.f / 16.f));
                S[d] = dec * S[d] + bf2f(AK[(size_t)row * 256 + h * 64 + d]) * v;
                if (lat) o += bf2f(AQ[(size_t)row * 256 + h * 64 + d]) * S[d];
            }
            if (lat) O[(size_t)row * 512 + h * 128 + e] = (bf16)f2bf(o);
        }
    }
}
__device__ __forceinline__ void p5_y(Frame& F) {
    for (int row = F.gw; row < NTOK; row += F.NGW) {
#pragma unroll
        for (int br = 0; br < 2; ++br) {
            const bf16* OF = (const bf16*)(F.ws + (br ? WS_OBF : WS_OAF)); const bf16* OB = (const bf16*)(F.ws + (br ? WS_OBB : WS_OAB));
            const bf16* G = (const bf16*)(F.ws + (br ? WS_BG : WS_AG)); bf16* Y = (bf16*)(F.ws + (br ? WS_YB : WS_YA)); const float* on = br ? F.gdn_onorm : F.gla_onorm;
            const size_t off = (size_t)row * 512 + 8 * F.lane; float a[8], bb[8], g[8];
            unpack8(*(const v4u*)(OF + off), a); unpack8(*(const v4u*)(OB + off), bb); unpack8(*(const v4u*)(G + off), g);
            float ss = 0.f;
#pragma unroll
            for (int e = 0; e < 8; ++e) { a[e] += bb[e]; ss += a[e] * a[e]; }
            ss = grp16_sum(ss); const float rs = 1.f / sqrtf(ss * (1.f / 128.f) + EPSV);
            const f32x4* onv = (const f32x4*)(on + ((8 * F.lane) & 127)); const f32x4 o0 = onv[0], o1 = onv[1];
#pragma unroll
            for (int e = 0; e < 4; ++e) { a[e] = a[e] * rs * o0[e] * g[e]; a[4 + e] = a[4 + e] * rs * o1[e] * g[4 + e]; }
            *(v4u*)(Y + off) = pack8(a);
        }
    }
}
__device__ __forceinline__ void p8_final(Frame& F) {
    const float* ROWSS = (const float*)(F.ws + WS_ROWSS);
    for (int row = F.gw; row < NTOK; row += F.NGW) {
        const float rs = 1.f / sqrtf(ROWSS[row] * (1.f / DM) + EPSV);
        f32x4* y = (f32x4*)(F.out + (size_t)row * DM) + F.lane; const f32x4* g = (const f32x4*)F.final_g + F.lane;
#pragma unroll
        for (int j = 0; j < 4; ++j) y[64 * j] = y[64 * j] * rs * g[64 * j];
    }
}

typedef short bf16x8_t __attribute__((ext_vector_type(8)));
typedef float f4 __attribute__((ext_vector_type(4)));
#define MFMA16(a, b, c) __builtin_amdgcn_mfma_f32_16x16x32_bf16((a), (b), (c), 0, 0, 0)
constexpr int NCH = 36;
constexpr int NITEM = BATCH * 4 * NCH;
__device__ __forceinline__ int chunk_row0(int b, int cid) { return cid < 4 ? NTOK + b * CTXL + cid * 64 : b * SEQ + (cid - 4) * 64; }
__device__ __forceinline__ int step_cid(int dir, int s) { return dir ? (s < 4 ? 3 - s : 35 - (s - 4)) : s; }
typedef __bf16 bf16x2_t __attribute__((ext_vector_type(2)));
typedef float f2_t __attribute__((ext_vector_type(2)));
__device__ __forceinline__ unsigned cvtpk(float lo, float hi) { const f2_t v = {lo, hi}; return __builtin_bit_cast(unsigned, __builtin_convertvector(v, bf16x2_t)); }
__device__ __forceinline__ int img_off_perm(int row, int k, int nks) { const int o = k & 31; return (((row >> 4) * nks + (k >> 5)) * 64 + (((o & 15) >> 2) << 4) + (row & 15)) * 8 + (o & 3) + ((o >> 4) << 2); }
__device__ __forceinline__ int img_off_nat(int row, int k, int nks) { const int o = k & 31; return (((row >> 4) * nks + (k >> 5)) * 64 + ((o >> 3) << 4) + (row & 15)) * 8 + (o & 7); }

__device__ __forceinline__ v4u lds_frag_perm(const LAS bf16* t, int LD, int row0, int k0, int lane) {
    const LAS bf16* p = t + (row0 + (lane & 15)) * LD + k0 + 4 * (lane >> 4); const v2u a = *(const LAS v2u*)p, b = *(const LAS v2u*)(p + 16); return (v4u){a.x, a.y, b.x, b.y};
}
__device__ __forceinline__ v4u lds_frag_nat(const LAS bf16* t, int LD, int row0, int k0, int lane) {
    return *(const LAS v4u*)(t + (row0 + (lane & 15)) * LD + k0 + 8 * (lane >> 4));
}
constexpr int A_LD = 136, A_OUT = 3 * 66 * A_LD * 2, A_NPC = 3 * 66 * 16;
struct ConvStage { v4u r[7]; };
__device__ __forceinline__ void conv_issue(Frame& F, int item, int wh, ConvStage& st) {
    const int cid = item % NCH, h = (item / NCH) & 3, b = item / (NCH * 4); const bool lat = cid >= 4;
    const bf16* PRE = (const bf16*)(F.ws + WS_PRE) + wh * 512 + h * 128;
#pragma unroll
    for (int k = 0; k < 7; ++k) { const int pc = F.tid + 512 * k; v4u val = {0u, 0u, 0u, 0u};
        if (pc < A_NPC) { const int dyi = pc / (66 * 16), rem = pc % (66 * 16), tk = rem >> 4, l = rem & 15; bool ok; int nrow;
            if (lat) { const int yy = cid - 4 + dyi - 1, xx = tk - 1; ok = yy >= 0 && yy < 32 && xx >= 0 && xx < 64; nrow = b * SEQ + yy * 64 + xx; }
            else { const int tt = cid * 64 + tk - 1; ok = dyi == 1 && tt >= 0 && tt < CTXL; nrow = NTOK + b * CTXL + tt; }
            if (ok) val = *(const v4u*)(PRE + (size_t)nrow * 1536 + 8 * l); }
        st.r[k] = val; }
}
__device__ __forceinline__ void conv_commit(Frame& F, const ConvStage& st) {
    LAS bf16* IN = (LAS bf16*)F.lds;
#pragma unroll
    for (int k = 0; k < 7; ++k) { const int pc = F.tid + 512 * k; if (pc < A_NPC) *(LAS v4u*)(IN + (pc >> 4) * A_LD + 8 * (pc & 15)) = st.r[k]; }
}
__device__ __forceinline__ void conv_pass(Frame& F, int item, int wh) {
    const int cid = item % NCH, h = (item / NCH) & 3, b = item / (NCH * 4); const bool lat = cid >= 4;
    const LAS bf16* IN = (const LAS bf16*)F.lds; LAS bf16* OUT = (LAS bf16*)(F.lds + A_OUT);
    const int l16 = F.tid & 15, tg = F.tid >> 4, lane = F.lane, w = F.wave;
    float acc[2][8];
#pragma unroll
    for (int t = 0; t < 2; ++t)
#pragma unroll
        for (int e = 0; e < 8; ++e) acc[t][e] = 0.f;
    const float* cwb = F.gdn_conv + wh * 512 + h * 128 + 8 * l16;
#pragma unroll
    for (int dy = 0; dy < 3; ++dy) {
        if (!lat && dy != 1) continue;
        float v[4][8];
#pragma unroll
        for (int j = 0; j < 4; ++j) unpack8(*(const LAS v4u*)(IN + (dy * 66 + 2 * tg + j) * A_LD + 8 * l16), v[j]);
#pragma unroll
        for (int dx = 0; dx < 3; ++dx) { const f32x4* cw = (const f32x4*)(cwb + (size_t)(dy * 3 + dx) * 1536); const f32x4 c0 = cw[0], c1 = cw[1];
#pragma unroll
            for (int t = 0; t < 2; ++t)
#pragma unroll
                for (int e = 0; e < 4; ++e) { acc[t][e] += v[t + dx][e] * c0[e]; acc[t][4 + e] += v[t + dx][4 + e] * c1[e]; } }
    }
#pragma unroll
    for (int t = 0; t < 2; ++t) { float ss = 0.f;
#pragma unroll
        for (int e = 0; e < 8; ++e) { acc[t][e] = fsilu(acc[t][e]); ss += acc[t][e] * acc[t][e]; }
        if (wh < 2) { ss = grp16_sum(ss); float scl = 1.f / sqrtf(ss + EPSV); if (wh == 0) scl *= 0.08838834764831845f;
#pragma unroll
            for (int e = 0; e < 8; ++e) acc[t][e] *= scl; }
        *(LAS v4u*)(OUT + (2 * tg + t) * A_LD + 8 * l16) = pack8(acc[t]); }
    LDS_WAIT(); __syncthreads();
    const int li = lat ? ((b * 4 + h) * 32 + cid - 4) : 0;
    if (wh < 2) {
        bf16* IMG = wh == 0 ? (bf16*)((unsigned char*)F.out + DO_QIMG) + (size_t)li * 8192 : (bf16*)(F.ws + WS_KIMG) + (size_t)item * 8192;
#pragma unroll
        for (int k = 0; k < 2; ++k) { const int f = 2 * w + k; *(v4u*)(IMG + (f * 64 + lane) * 8) = lds_frag_perm(OUT, A_LD, (f >> 2) * 16, (f & 3) * 32, lane); }
    }
    if (wh == 1) {
        bf16* KTIMG = (bf16*)(F.ws + WS_KTIMG) + (size_t)item * 8192; const int r = lane & 15, kq = lane >> 4;
#pragma unroll
        for (int k = 0; k < 2; ++k) { const int f = 2 * w + k, u = f >> 1, ks = f & 1; const LAS bf16* cp = OUT + (32 * ks + 4 * kq) * A_LD + 16 * u + r;
            unsigned e0 = cp[0], e1 = cp[A_LD], e2 = cp[2 * A_LD], e3 = cp[3 * A_LD], e4 = cp[16 * A_LD], e5 = cp[17 * A_LD], e6 = cp[18 * A_LD], e7 = cp[19 * A_LD];
            *(v4u*)(KTIMG + (f * 64 + lane) * 8) = (v4u){e0 | (e1 << 16), e2 | (e3 << 16), e4 | (e5 << 16), e6 | (e7 << 16)}; }
    }
    if (wh == 2) {
        bf16* VT = (bf16*)(F.ws + WS_VT) + (size_t)item * 8192;
#pragma unroll
        for (int k = 0; k < 2; ++k) { const int pcx = F.tid + 512 * k, dv = pcx >> 3, p0 = (pcx & 7) * 8; const LAS bf16* cp = OUT + p0 * A_LD + dv;
            unsigned e0 = cp[0], e1 = cp[A_LD], e2 = cp[2 * A_LD], e3 = cp[3 * A_LD], e4 = cp[4 * A_LD], e5 = cp[5 * A_LD], e6 = cp[6 * A_LD], e7 = cp[7 * A_LD];
            *(v4u*)(VT + dv * 64 + p0) = (v4u){e0 | (e1 << 16), e2 | (e3 << 16), e4 | (e5 << 16), e6 | (e7 << 16)}; }
    }
    LDS_WAIT(); __syncthreads();
}
__device__ __forceinline__ int p3a_conv_all(Frame& F) {
    int nit = 0; for (int item = F.vcu; item < NITEM; item += F.G) ++nit;
    ConvStage st;
    int item = F.vcu, wh = (item % NCH) >= 4 ? 0 : 1;
    if (nit > 0) conv_issue(F, item, wh, st);
    for (int k = 0; k < nit; ) {
        conv_commit(F, st); LDS_WAIT(); __syncthreads();
        int nitem = item, nwh = wh + 1, nk = k; if (nwh > 2) { nitem = item + F.G; nk = k + 1; nwh = (nitem % NCH) >= 4 ? 0 : 1; }
        if (nk < nit) conv_issue(F, nitem, nwh, st);
        conv_pass(F, item, wh);
        item = nitem; wh = nwh; k = nk;
    }
    return nit;
}
__device__ __forceinline__ float wave_prefix(float v, int lane) {
#pragma unroll
    for (int o = 1; o < 64; o <<= 1) { const float t = __shfl_up(v, o); if (lane >= o) v += t; }
    return v;
}
__device__ __forceinline__ void p3b_gdn(Frame& F, int item, int dir, LAS unsigned char* scr) {
    int lane_ = F.lane; asm volatile("" : "+v"(lane_));
    const int lane = lane_, cid = item % NCH, h = (item / NCH) & 3, b = item / (NCH * 4); const bool lat = cid >= 4;
    const int row0 = chunk_row0(b, cid);
    const float* SM = (const float*)(F.ws + WS_SM);
    const float beta = 1.f / (1.f + __expf(-SM[(size_t)(row0 + lane) * NSM + 32 + dir * 4 + h]));
    const float g = -expf(F.gdn_a_log[dir * 4 + h]) * softplusf_(SM[(size_t)(row0 + lane) * NSM + 40 + dir * 4 + h] + F.gdn_dt_bias[dir * 4 + h]);
    float gam; { const float gs = dir ? __shfl(g, 63 - lane) : g; const float pf = wave_prefix(gs, lane); gam = dir ? __shfl(pf, 63 - lane) : pf; }
    const float gl = __shfl(gam, dir ? 0 : 63);
    float* SC = (float*)(F.ws + WS_SCAL) + (size_t)(item * 2 + dir) * 256;
    SC[lane] = __expf(gam); SC[64 + lane] = __expf(gl - gam); SC[128 + lane] = beta; if (lane == 0) SC[192] = __expf(gl);
    const bf16* KIMG = (const bf16*)(F.ws + WS_KIMG) + (size_t)item * 8192;
    bf16x8_t kf[16];
#pragma unroll
    for (int f = 0; f < 16; ++f) kf[f] = *(const bf16x8_t*)(KIMG + (f * 64 + lane) * 8);
    LAS float* As = (LAS float*)scr;
    const int c = lane & 15, q = lane >> 4;
#pragma unroll
    for (int rt = 0; rt < 4; ++rt)
#pragma unroll
        for (int ct = 0; ct < 4; ++ct) {
            f4 acc = {0.f, 0.f, 0.f, 0.f};
            const bool need = dir ? (ct >= rt) : (ct <= rt);
            if (need) {
#pragma unroll
                for (int ks = 0; ks < 4; ++ks) acc = MFMA16(kf[rt * 4 + ks], kf[ct * 4 + ks], acc); }
            const int pc = 16 * ct + c;
#pragma unroll
            for (int i = 0; i < 4; ++i) { const int pr = 16 * rt + 4 * q + i; const bool keep = need && (dir ? (pc > pr) : (pc < pr));
                const float sb_ = __shfl(beta, pr), sg_ = __shfl(gam, pr) - __shfl(gam, pc);
                As[pr * 64 + pc] = keep ? sb_ * acc[i] * __expf(sg_) : 0.f; }
        }
    LDS_WAIT();
    const int blk = lane >> 4, cs = lane & 15; float T[16];
#pragma unroll
    for (int is = 0; is < 16; ++is) { const LAS float* arow = As + (16 * blk + (dir ? 15 - is : is)) * 64 + 16 * blk; float a0 = (is == cs) ? 1.f : 0.f;
#pragma unroll
        for (int js = 0; js < is; ++js) a0 -= arow[dir ? 15 - js : js] * T[js];
        T[is] = a0; }
    asm volatile("" ::: "memory");
    LAS bf16* Dt = (LAS bf16*)(scr + 16384);
    { const int tcol = dir ? 15 - cs : cs;
#pragma unroll
        for (int is = 0; is < 16; ++is) Dt[(16 * blk + (dir ? 15 - is : is)) * 16 + tcol] = (bf16)f2bf(T[is]); }
    LDS_WAIT();
    bf16* TBIMG = (bf16*)(F.ws + WS_TBIMG) + (size_t)(item * 2 + dir) * 4096;
#pragma unroll
    for (int bb = 0; bb < 4; ++bb) { const v2u d = *(const LAS v2u*)(Dt + (16 * bb + c) * 16 + 4 * q); *(v4u*)(TBIMG + (bb * 64 + lane) * 8) = (v4u){d.x, d.y, 0u, 0u}; }
#pragma unroll
    for (int n = 0; n < 4; ++n) { const int rt = dir ? (2 - n > 0 ? 2 - n : 0) : (n + 1 < 3 ? n + 1 : 3), ks = dir ? (n != 3) : (n == 3);
        const LAS float* ap = As + (16 * rt + c) * 64 + 32 * ks + 4 * q; f4 p0 = *(const LAS f4*)ap, p1 = *(const LAS f4*)(ap + 16);
        if (ks == (rt >> 1)) { if (rt & 1) p1 = (f4){0.f, 0.f, 0.f, 0.f}; else p0 = (f4){0.f, 0.f, 0.f, 0.f}; }
        *(v4u*)(TBIMG + ((4 + n) * 64 + lane) * 8) = (v4u){cvtpk(-p0[0], -p0[1]), cvtpk(-p0[2], -p0[3]), cvtpk(-p1[0], -p1[1]), cvtpk(-p1[2], -p1[3])}; }
    if (!lat) { LDS_WAIT(); return; }
    LDS_WAIT();
    const bf16* QIMG = (const bf16*)((unsigned char*)F.out + DO_QIMG) + (size_t)((b * 4 + h) * 32 + cid - 4) * 8192;
    LAS bf16* Aq = (LAS bf16*)scr;
#pragma unroll
    for (int rt = 0; rt < 4; ++rt) {
        bf16x8_t qf[4];
#pragma unroll
        for (int ks = 0; ks < 4; ++ks) qf[ks] = *(const bf16x8_t*)(QIMG + ((rt * 4 + ks) * 64 + lane) * 8);
#pragma unroll
        for (int ct = 0; ct < 4; ++ct) {
            f4 acc = {0.f, 0.f, 0.f, 0.f};
            const bool need = dir ? (ct >= rt) : (ct <= rt);
            if (need) {
#pragma unroll
                for (int ks = 0; ks < 4; ++ks) acc = MFMA16(qf[ks], kf[ct * 4 + ks], acc); }
            const int pc = 16 * ct + c;
#pragma unroll
            for (int i = 0; i < 4; ++i) { const int pr = 16 * rt + 4 * q + i; const bool keep = need && (dir ? (pc >= pr) : (pc <= pr));
                const float sg_ = __shfl(gam, pr) - __shfl(gam, pc);
                Aq[pr * 72 + pc] = (bf16)f2bf(keep ? acc[i] * __expf(sg_) : 0.f); }
        }
    }
    LDS_WAIT();
    bf16* AQKIMG = (bf16*)((unsigned char*)F.out + DO_AQKIMG) + (size_t)(((b * 4 + h) * 32 + cid - 4) * 2 + dir) * 4096;
#pragma unroll
    for (int fr = 0; fr < 8; ++fr) *(v4u*)(AQKIMG + (fr * 64 + lane) * 8) = lds_frag_perm(Aq, 72, (fr >> 1) * 16, (fr & 1) * 32, lane);
    LDS_WAIT();
}
__device__ __forceinline__ float gla_alog(const float (&lrv)[16], int p, const float (&up)[16], float ub) {
    float u = ub;
#pragma unroll
    for (int r = 0; r < 16; ++r) u += __builtin_bit_cast(float, __builtin_amdgcn_readlane(__builtin_bit_cast(int, lrv[r]), p)) * up[r];
    return (fminf(u, 0.f) - __logf(1.f + __expf(-fabsf(u)))) * (1.f / 16.f);
}
__device__ __forceinline__ void p3b_gla(Frame& F, int item, int dir, LAS unsigned char* scr) {
    int lane_ = F.lane; asm volatile("" : "+v"(lane_));
    const int lane = lane_, cid = item % NCH, h = (item / NCH) & 3, b = item / (NCH * 4); const bool lat = cid >= 4;
    const int row0 = chunk_row0(b, cid);
    LAS bf16* Qe = (LAS bf16*)scr; LAS bf16* Ke = (LAS bf16*)(scr + 9216);
    float lrv[16];
    {   const f4* ar = (const f4*)((const float*)(F.ws + WS_SM) + (size_t)(row0 + lane) * NSM + dir * 16);
#pragma unroll
        for (int j = 0; j < 4; ++j) { const f4 t = ar[j]; lrv[4 * j] = t[0]; lrv[4 * j + 1] = t[1]; lrv[4 * j + 2] = t[2]; lrv[4 * j + 3] = t[3]; }
        const bf16* AKt = (const bf16*)(F.ws + WS_AK) + (size_t)row0 * 256 + h * 64; const bf16* AQt = (const bf16*)(F.ws + WS_AQ) + (size_t)row0 * 256 + h * 64;
#pragma unroll
        for (int j = 0; j < 8; ++j) { const int pc = lane + 64 * j, r = pc >> 3, ch = pc & 7;
            *(LAS v4u*)(Ke + r * 72 + ch * 8) = *(const v4u*)(AKt + r * 256 + ch * 8);
            if (lat) *(LAS v4u*)(Qe + r * 72 + ch * 8) = *(const v4u*)(AQt + r * 256 + ch * 8); }
    }
    float up[16];
#pragma unroll
    for (int r = 0; r < 16; ++r) up[r] = F.gla_up[(size_t)(dir * 16 + r) * 256 + h * 64 + lane];
    const float ub = F.gla_ub[dir * 256 + h * 64 + lane];
    float bl = 0.f;
#pragma unroll 4
    for (int p = 0; p < 64; ++p) bl += gla_alog(lrv, p, up, ub);
    ((float*)(F.ws + WS_EBL))[(size_t)(item * 2 + dir) * 64 + lane] = __expf(bl);
    bf16* KDTIMG = (bf16*)(F.ws + WS_KDTIMG) + (size_t)(item * 2 + dir) * 4096;
    LDS_WAIT();
    float run = 0.f;
#pragma unroll 1
    for (int s8 = 0; s8 < 8; ++s8) { float kd[8], ko[8];
#pragma unroll
        for (int e = 0; e < 8; ++e) { const int sidx = s8 * 8 + e; const int p = dir ? 63 - sidx : sidx;
            run += gla_alog(lrv, p, up, ub); const float eb = __expf(run); const float kk = bf2f(Ke[p * 72 + lane]); const float qq = lat ? bf2f(Qe[p * 72 + lane]) : 0.f;
            Qe[p * 72 + lane] = (bf16)f2bf(qq * eb); Ke[p * 72 + lane] = (bf16)f2bf(kk * __builtin_amdgcn_rcpf(eb)); kd[e] = kk * __expf(bl - run); }
#pragma unroll
        for (int e = 0; e < 8; ++e) ko[e] = dir ? kd[7 - e] : kd[e];
        const int p0 = (dir ? 7 - s8 : s8) * 8;
        *(v4u*)(KDTIMG + (((lane >> 4) * 2 + (p0 >> 5)) * 64 + (((p0 & 31) >> 3) << 4) + (lane & 15)) * 8) = pack8(ko); }
    LDS_WAIT();
    if (!lat) return;
    const int c = lane & 15, q = lane >> 4;
    bf16* QEIMG = (bf16*)((unsigned char*)F.out + DO_QEIMG) + (size_t)(((b * 4 + h) * 32 + cid - 4) * 2 + dir) * 4096;
#pragma unroll
    for (int fr = 0; fr < 8; ++fr) *(v4u*)(QEIMG + (fr * 64 + lane) * 8) = lds_frag_perm(Qe, 72, (fr >> 1) * 16, (fr & 1) * 32, lane);
    f4 att[4][4];
#pragma unroll
    for (int rt = 0; rt < 4; ++rt)
#pragma unroll
        for (int ct = 0; ct < 4; ++ct) { f4 acc = {0.f, 0.f, 0.f, 0.f};
            if (dir ? (ct >= rt) : (ct <= rt)) {
#pragma unroll
                for (int ks = 0; ks < 2; ++ks) { const v4u a = lds_frag_nat(Qe, 72, rt * 16, ks * 32, lane), bb = lds_frag_nat(Ke, 72, ct * 16, ks * 32, lane);
                    acc = MFMA16(__builtin_bit_cast(bf16x8_t, a), __builtin_bit_cast(bf16x8_t, bb), acc); } }
            att[rt][ct] = acc; }
    LDS_WAIT();
    LAS bf16* At = (LAS bf16*)scr;
#pragma unroll
    for (int rt = 0; rt < 4; ++rt)
#pragma unroll
        for (int ct = 0; ct < 4; ++ct) { const int pc = 16 * ct + c;
#pragma unroll
            for (int i = 0; i < 4; ++i) { const int pr = 16 * rt + 4 * q + i; const bool keep = dir ? (pc >= pr) : (pc <= pr);
                At[pr * 72 + pc] = (bf16)f2bf(keep ? att[rt][ct][i] : 0.f); } }
    LDS_WAIT();
    bf16* ATTIMG = (bf16*)((unsigned char*)F.out + DO_ATTIMG) + (size_t)(((b * 4 + h) * 32 + cid - 4) * 2 + dir) * 4096;
#pragma unroll
    for (int fr = 0; fr < 8; ++fr) *(v4u*)(ATTIMG + (fr * 64 + lane) * 8) = lds_frag_nat(At, 72, (fr >> 1) * 16, (fr & 1) * 32, lane);
    LDS_WAIT();
}
#ifndef PROBE_REP_A
#define PROBE_REP_A 1
#endif
#ifndef PROBE_REP_GDN
#define PROBE_REP_GDN 1
#endif
#ifndef PROBE_REP_GLA
#define PROBE_REP_GLA 1
#endif
__device__ __forceinline__ void p3_prep(Frame& F) {
    int nit = 0;
#if !DBG_NAIVE_GDN
    for (int rep = 0; rep < PROBE_REP_A; ++rep) nit = p3a_conv_all(F);
#else
    for (int item = F.vcu; item < NITEM; item += F.G) ++nit;
#endif
    if (F.tid == 0) F.MISC[16] = 0u;
    VM_WAIT(); __syncthreads();
    LAS unsigned char* scr = F.lds + F.wave * 18432;
    for (;;) {
        unsigned idx = 0u; if (F.lane == 0) idx = __hip_atomic_fetch_add((LAS unsigned*)(F.lds + MISC_OFF) + 16, 1u, __ATOMIC_RELAXED, __HIP_MEMORY_SCOPE_WORKGROUP);
        idx = (unsigned)__builtin_amdgcn_readfirstlane((int)idx);
        if (idx >= (unsigned)(nit * 4)) break;
        const int kind = idx >= (unsigned)(nit * 2), j = kind ? (int)idx - nit * 2 : (int)idx, item = F.vcu + (j >> 1) * F.G, dir = j & 1;
        if (kind == 0) {
#if !DBG_NAIVE_GDN
            for (int rep = 0; rep < PROBE_REP_GDN; ++rep) p3b_gdn(F, item, dir, scr);
#endif
        } else {
#if !DBG_NAIVE_GLA
            for (int rep = 0; rep < PROBE_REP_GLA; ++rep) p3b_gla(F, item, dir, scr);
#endif
        }
    }
}

__device__ __forceinline__ void glds1k(const bf16* g, LAS unsigned char* l, int lane) { __builtin_amdgcn_global_load_lds((const unsigned*)(g + lane * 8), (LAS unsigned*)l, 16, 0, 0); }
__device__ __forceinline__ void gdn_stage(Frame& F, int b, int h, int dir, int s) {
    const int cid = step_cid(dir, s), item = (b * 4 + h) * NCH + cid; const bool lat = cid >= 4; const size_t li = (size_t)(lat ? ((b * 4 + h) * 32 + cid - 4) : 0);
    LAS unsigned char* buf = F.lds + (s & 1) * 66560;
    if (F.wave == 0) glds1k((const bf16*)((const float*)(F.ws + WS_SCAL) + (size_t)(item * 2 + dir) * 256), buf + 65536, F.lane);
#pragma unroll
    for (int k = 0; k < 8; ++k) { const int fr = 8 * F.wave + k; const bf16* src;
        if (fr < 16) src = (const bf16*)(F.ws + WS_KIMG) + (size_t)item * 8192 + fr * 512;
        else if (fr < 32) { if (!lat) continue; src = (const bf16*)((unsigned char*)F.out + DO_QIMG) + li * 8192 + (fr - 16) * 512; }
        else if (fr < 48) src = (const bf16*)(F.ws + WS_KTIMG) + (size_t)item * 8192 + (fr - 32) * 512;
        else if (fr < 56) src = (const bf16*)(F.ws + WS_TBIMG) + (size_t)(item * 2 + dir) * 4096 + (fr - 48) * 512;
        else { if (!lat) continue; src = (const bf16*)((unsigned char*)F.out + DO_AQKIMG) + (li * 2 + dir) * 4096 + (fr - 56) * 512; }
        glds1k(src, buf + fr * 1024, F.lane); }
}
__device__ __forceinline__ void gla_stage(Frame& F, int b, int h, int dir, int s) {
    const int cid = step_cid(dir, s), item = (b * 4 + h) * NCH + cid; const bool lat = cid >= 4; const size_t li = (size_t)(lat ? ((b * 4 + h) * 32 + cid - 4) : 0);
    LAS unsigned char* buf = F.lds + (s & 1) * 32768;
#pragma unroll
    for (int k = 0; k < 3; ++k) { const int fr = 3 * F.wave + k; const bf16* src;
        if (fr < 8) { if (!lat) continue; src = (const bf16*)((unsigned char*)F.out + DO_QEIMG) + (li * 2 + dir) * 4096 + fr * 512; }
        else if (fr < 16) { if (!lat) continue; src = (const bf16*)((unsigned char*)F.out + DO_ATTIMG) + (li * 2 + dir) * 4096 + (fr - 8) * 512; }
        else src = (const bf16*)(F.ws + WS_KDTIMG) + (size_t)(item * 2 + dir) * 4096 + (fr - 16) * 512;
        glds1k(src, buf + fr * 1024, F.lane); }
}
struct GdnAux { v2u V[4]; };
__device__ __forceinline__ void gdn_aux_load(Frame& F, int b, int h, int dir, int s, int col, int q, GdnAux& a) {
    const int cid = step_cid(dir, s), item = (b * 4 + h) * NCH + cid;
    const bf16* VTp = (const bf16*)(F.ws + WS_VT) + (size_t)item * 8192 + col * 64;
#pragma unroll
    for (int rt = 0; rt < 4; ++rt) a.V[rt] = *(const v2u*)(VTp + 16 * rt + 4 * q);
}
__device__ __forceinline__ bf16x8_t pack_b(const f4& x, const f4& y) { const v4u t = {cvtpk(x[0], x[1]), cvtpk(x[2], x[3]), cvtpk(y[0], y[1]), cvtpk(y[2], y[3])}; return __builtin_bit_cast(bf16x8_t, t); }
template <int DIR>
__device__ __forceinline__ void p4_gdn(Frame& F, int idx) {
    int lane_ = F.lane; asm volatile("" : "+v"(lane_));
    const int half = idx & 1, dir = DIR, h = (idx >> 2) & 3, b = idx >> 4; const int lane = lane_, w = F.wave, c = lane & 15, q = lane >> 4;
    const int col = half * 64 + 16 * (w & 3) + c;
    bf16* O = (bf16*)(F.ws + (dir ? WS_OBB : WS_OBF));
    const f4 Z = {0.f, 0.f, 0.f, 0.f};
    f4 S[8];
#pragma unroll
    for (int u = 0; u < 8; ++u) S[u] = Z;
    GdnAux cur, nxt;
    gdn_stage(F, b, h, dir, 0); if (w < 4) gdn_aux_load(F, b, h, dir, 0, col, q, cur); VM_WAIT(); __syncthreads();
#pragma unroll 1
    for (int s = 0; s < NCH; ++s) {
        if (s + 1 < NCH) { gdn_stage(F, b, h, dir, s + 1); if (w < 4) gdn_aux_load(F, b, h, dir, s + 1, col, q, nxt); }
        if (w < 4) {
            const int cid = step_cid(dir, s); const bool lat = cid >= 4;
            const LAS unsigned char* buf = F.lds + (s & 1) * 66560;
#ifdef EXP_SCAL_GLOBAL
            const float* SCL = (const float*)(F.ws + WS_SCAL) + (size_t)(((b * 4 + h) * NCH + cid) * 2 + dir) * 256;
#define SCLP const
#else
            const LAS float* SCL = (const LAS float*)(buf + 65536);
#define SCLP const LAS
#endif
#define FRAG(off, f) (*(const LAS bf16x8_t*)(buf + (off) + ((f) * 64 + lane) * 16))
            bf16x8_t Bs[4];
#pragma unroll
            for (int ks = 0; ks < 4; ++ks) Bs[ks] = pack_b(S[2 * ks], S[2 * ks + 1]);
            f4 KS[4], QS[4];
#pragma unroll
            for (int rt = 0; rt < 4; ++rt) { f4 a = Z, a2 = Z;
#pragma unroll
                for (int ks = 0; ks < 4; ++ks) { a = MFMA16(FRAG(0, rt * 4 + ks), Bs[ks], a); if (lat) a2 = MFMA16(FRAG(16384, rt * 4 + ks), Bs[ks], a2); }
                KS[rt] = a; QS[rt] = a2; }
            f4 tm[4], W[4];
#pragma unroll
            for (int rt = 0; rt < 4; ++rt) { const f4 Vr = {bflo(cur.V[rt].x), bfhi(cur.V[rt].x), bflo(cur.V[rt].y), bfhi(cur.V[rt].y)};
                tm[rt] = *(SCLP f4*)(SCL + 128 + 16 * rt + 4 * q) * (Vr - *(SCLP f4*)(SCL + 16 * rt + 4 * q) * KS[rt]); }
            if (DIR == 0) {
                W[0] = MFMA16(FRAG(49152, 0), pack_b(tm[0], Z), Z);
                W[1] = MFMA16(FRAG(49152, 1), pack_b(MFMA16(FRAG(49152, 4), pack_b(W[0], Z), tm[1]), Z), Z);
                const bf16x8_t b01 = pack_b(W[0], W[1]);
                W[2] = MFMA16(FRAG(49152, 2), pack_b(MFMA16(FRAG(49152, 5), b01, tm[2]), Z), Z);
                W[3] = MFMA16(FRAG(49152, 3), pack_b(MFMA16(FRAG(49152, 7), pack_b(W[2], Z), MFMA16(FRAG(49152, 6), b01, tm[3])), Z), Z);
            } else {
                W[3] = MFMA16(FRAG(49152, 3), pack_b(tm[3], Z), Z);
                W[2] = MFMA16(FRAG(49152, 2), pack_b(MFMA16(FRAG(49152, 4), pack_b(Z, W[3]), tm[2]), Z), Z);
                const bf16x8_t b23 = pack_b(W[2], W[3]);
                W[1] = MFMA16(FRAG(49152, 1), pack_b(MFMA16(FRAG(49152, 5), b23, tm[1]), Z), Z);
                W[0] = MFMA16(FRAG(49152, 0), pack_b(MFMA16(FRAG(49152, 7), pack_b(Z, W[1]), MFMA16(FRAG(49152, 6), b23, tm[0])), Z), Z);
            }
            bf16x8_t Bv[2], Bw[2];
#pragma unroll
            for (int ks = 0; ks < 2; ++ks) { Bv[ks] = pack_b(W[2 * ks], W[2 * ks + 1]); Bw[ks] = pack_b(W[2 * ks] * *(SCLP f4*)(SCL + 64 + 32 * ks + 4 * q), W[2 * ks + 1] * *(SCLP f4*)(SCL + 64 + 32 * ks + 16 + 4 * q)); }
            if (lat) {
                const int trow0 = chunk_row0(b, cid);
#pragma unroll
                for (int rt = 0; rt < 4; ++rt) { f4 a = *(SCLP f4*)(SCL + 16 * rt + 4 * q) * QS[rt];
#pragma unroll
                    for (int ks = 0; ks < 2; ++ks) a = MFMA16(FRAG(57344, rt * 2 + ks), Bv[ks], a);
#pragma unroll
                    for (int i = 0; i < 4; ++i) O[(size_t)(trow0 + 16 * rt + 4 * q + i) * 512 + h * 128 + col] = (bf16)f2bf(a[i]); }
            }
            const float egt = SCL[192];
#pragma unroll
            for (int u = 0; u < 8; ++u) { f4 a = S[u] * egt;
#pragma unroll
                for (int ks = 0; ks < 2; ++ks) a = MFMA16(FRAG(32768, u * 2 + ks), Bw[ks], a);
                S[u] = a; }
#undef FRAG
            cur = nxt;
        }
        VM_WAIT(); __syncthreads();
    }
}
__device__ __forceinline__ void p4_gla(Frame& F, int idx) {
    int lane_ = F.lane; asm volatile("" : "+v"(lane_));
    const int dir = idx & 1, h = (idx >> 1) & 3, b = idx >> 3; const int lane = lane_, w = F.wave, c = lane & 15, q = lane >> 4;
    const int col = 16 * w + c;
    bf16* O = (bf16*)(F.ws + (dir ? WS_OAB : WS_OAF));
    f4 S[4];
#pragma unroll
    for (int u = 0; u < 4; ++u) S[u] = (f4){0.f, 0.f, 0.f, 0.f};
    gla_stage(F, b, h, dir, 0); VM_WAIT(); __syncthreads();
#pragma unroll 1
    for (int s = 0; s < NCH; ++s) {
        if (s + 1 < NCH) gla_stage(F, b, h, dir, s + 1);
        {
            const int cid = step_cid(dir, s), item = (b * 4 + h) * NCH + cid; const bool lat = cid >= 4;
            const LAS unsigned char* buf = F.lds + (s & 1) * 32768;
            const float* EB = (const float*)(F.ws + WS_EBL) + (size_t)(item * 2 + dir) * 64;
            const bf16* VTp = (const bf16*)(F.ws + WS_VTA) + (size_t)item * 8192 + col * 64;
            bf16x8_t Bv[2];
#pragma unroll
            for (int ks = 0; ks < 2; ++ks) Bv[ks] = *(const bf16x8_t*)(VTp + 32 * ks + 8 * q);
            if (lat) {
                bf16x8_t Bs[2];
#pragma unroll
                for (int ks = 0; ks < 2; ++ks) { const v4u t = {cvtpk(S[2 * ks][0], S[2 * ks][1]), cvtpk(S[2 * ks][2], S[2 * ks][3]), cvtpk(S[2 * ks + 1][0], S[2 * ks + 1][1]), cvtpk(S[2 * ks + 1][2], S[2 * ks + 1][3])}; Bs[ks] = __builtin_bit_cast(bf16x8_t, t); }
                const int trow0 = chunk_row0(b, cid);
#pragma unroll
                for (int rt = 0; rt < 4; ++rt) { f4 a = {0.f, 0.f, 0.f, 0.f};
#pragma unroll
                    for (int ks = 0; ks < 2; ++ks) { a = MFMA16(*(const LAS bf16x8_t*)(buf + ((rt * 2 + ks) * 64 + lane) * 16), Bs[ks], a);
                        a = MFMA16(*(const LAS bf16x8_t*)(buf + 8192 + ((rt * 2 + ks) * 64 + lane) * 16), Bv[ks], a); }
#pragma unroll
                    for (int i = 0; i < 4; ++i) O[(size_t)(trow0 + 16 * rt + 4 * q + i) * 512 + h * 128 + col] = (bf16)f2bf(a[i]); }
            }
#pragma unroll
            for (int u = 0; u < 4; ++u) { f4 a = S[u] * *(const f4*)(EB + 16 * u + 4 * q);
#pragma unroll
                for (int ks = 0; ks < 2; ++ks) a = MFMA16(*(const LAS bf16x8_t*)(buf + 16384 + ((u * 2 + ks) * 64 + lane) * 16), Bv[ks], a);
                S[u] = a; }
        }
        VM_WAIT(); __syncthreads();
    }
}

__global__ void __launch_bounds__(NWAVES * 64, 2) mk_fwd(Args args) {
    extern __shared__ __attribute__((aligned(16))) unsigned char lds[];
    Frame F;
    F.lds = (LAS unsigned char*)lds; F.MISC = (volatile LAS unsigned*)(F.lds + MISC_OFF);
    F.tid = threadIdx.x; F.lane = F.tid & 63; F.wave = __builtin_amdgcn_readfirstlane(F.tid >> 6);
    F.G = gridDim.x; { const int bx = blockIdx.x; F.vcu = (F.G % 8 == 0) ? (bx % 8) * (F.G / 8) + bx / 8 : bx; }
    F.gw = F.vcu * NWAVES + F.wave; F.NGW = F.G * NWAVES;
    F.ws = args.ws; F.out = args.out; F.ctl = (unsigned*)(args.ws + WS_CTL);
    F.x = args.in[0]; F.c = args.in[1]; F.ctx = args.in[2]; F.c_ctx = args.in[3]; F.w_mod = args.in[4]; F.b_mod = args.in[5]; F.norm_g = args.in[6]; F.w_in = args.in[7];
    F.gla_up = args.in[8]; F.gla_ub = args.in[9]; F.gla_onorm = args.in[10]; F.gdn_conv = args.in[11]; F.gdn_a_log = args.in[12]; F.gdn_dt_bias = args.in[13]; F.gdn_onorm = args.in[14];
    F.w_gla_out = args.in[15]; F.w_gdn_out = args.in[16]; F.b_gate = args.in[17]; F.w_o = args.in[18]; F.final_g = args.in[19];
    for (int u = F.tid; u < (LDS_BYTES - MISC_OFF) / 4; u += NWAVES * 64) ((LAS unsigned*)(F.lds + MISC_OFF))[u] = 0u;
    __syncthreads();
    XcdBarrier bar = xcd_barrier_post(F.ctl + CW_BAR, F.MISC + 8);
#define GRID_BAR() xcd_barrier(bar)
    unsigned char* ws = args.ws;
    bf16* H = (bf16*)(ws + WS_H);
    p0_prologue(F); GRID_BAR();
    p1_rows(F); GRID_BAR();
    {   pg8::Gemm g{H, (const bf16*)(ws + WS_WTIN), NROWS, 11 * 256, DM}; pg8::OrderA S; S.init(F.G, (int)blockIdx.x);
        pg8::EpiIn E{ws, (bf16*)args.out, (float*)(ws + WS_SM), F.b_gate, 0};
        pg8::gemm_phase<pg8::EpiIn, pg8::OrderA, PG8_ALIGN, PG8_SP2>(F.lds, g, S, E); }
    GRID_BAR();
#if DBG_NAIVE_GDN
    p3_conv(F);
#endif
    p3_prep(F); GRID_BAR();
#ifdef PROBE_DUP_P3
    p3_prep(F); GRID_BAR();
#endif
    if (F.vcu < 128) {
#if !DBG_NAIVE_GDN
        if ((F.vcu >> 1) & 1) p4_gdn<1>(F, F.vcu); else p4_gdn<0>(F, F.vcu);
#endif
    } else if (F.vcu < 192) {
#if !DBG_NAIVE_GLA
        p4_gla(F, F.vcu - 128);
#endif
    }
#if DBG_NAIVE_GDN || DBG_NAIVE_GLA
    p4_scan_naive(F);
#endif
    GRID_BAR();
#ifdef PROBE_DUP_P4
    if (F.vcu < 128) {
#if !DBG_NAIVE_GDN
        if ((F.vcu >> 1) & 1) p4_gdn<1>(F, F.vcu); else p4_gdn<0>(F, F.vcu);
#endif
    } else if (F.vcu < 192) {
#if !DBG_NAIVE_GLA
        p4_gla(F, F.vcu - 128);
#endif
    }
#if DBG_NAIVE_GDN || DBG_NAIVE_GLA
    p4_scan_naive(F);
#endif
    GRID_BAR();
#endif
    {   pg8::Gemm g{H, (const bf16*)(ws + WS_WTIN) + (size_t)2816 * DM, NTOK, 12 * 256, DM}; pg8::StaticOrder S; S.init(NTOK, 12 * 256, F.G, (int)blockIdx.x);
        pg8::EpiIn E{ws, (bf16*)args.out, (float*)(ws + WS_SM), F.b_gate, 11};
        pg8::gemm_phase<pg8::EpiIn, pg8::StaticOrder, PG8_ALIGN, PG8_SP2>(F.lds, g, S, E); }
    GRID_BAR();
#ifdef PROBE_DUP_P2B
    {   pg8::Gemm g{H, (const bf16*)(ws + WS_WTIN) + (size_t)2816 * DM, NTOK, 12 * 256, DM}; pg8::StaticOrder S; S.init(NTOK, 12 * 256, F.G, (int)blockIdx.x);
        pg8::EpiIn E{ws, (bf16*)args.out, (float*)(ws + WS_SM), F.b_gate, 11};
        pg8::gemm_phase<pg8::EpiIn, pg8::StaticOrder, PG8_ALIGN, PG8_SP2>(F.lds, g, S, E); }
    GRID_BAR();
#endif
    p5_y(F); GRID_BAR();
    {   pg8::Gemm g{(const bf16*)(ws + WS_YA), (const bf16*)(ws + WS_WTGA), NTOK, DM, 512}; pg8::StaticOrder S; S.init(NTOK, DM, F.G, (int)blockIdx.x);
        pg8::EpiGa E{(const bf16*)args.out, (float*)(ws + WS_TMP)};
        pg8::gemm_phase<pg8::EpiGa, pg8::StaticOrder, PG8_ALIGN, PG8_SP2>(F.lds, g, S, E); }
    GRID_BAR();
    {   pg8::Gemm g{(const bf16*)(ws + WS_YB), (const bf16*)(ws + WS_WTGD), NTOK, DM, 512}; pg8::StaticOrder S; S.init(NTOK, DM, F.G, (int)blockIdx.x);
        pg8::EpiGb E{(const bf16*)args.out, (const float*)(ws + WS_TMP), (bf16*)(ws + WS_MERGED)};
        pg8::gemm_phase<pg8::EpiGb, pg8::StaticOrder, PG8_ALIGN, PG8_SP2>(F.lds, g, S, E); }
    GRID_BAR();
    {   pg8::Gemm g{(const bf16*)(ws + WS_MERGED), (const bf16*)(ws + WS_WTO), NTOK, DM, DM}; pg8::StaticOrder S; S.init(NTOK, DM, F.G, (int)blockIdx.x);
        pg8::EpiOut E{F.x, (const float*)(ws + WS_MOD), args.out, (float*)(ws + WS_ROWSS)};
        pg8::gemm_phase<pg8::EpiOut, pg8::StaticOrder, PG8_ALIGN, PG8_SP2>(F.lds, g, S, E); }
    GRID_BAR();
    p8_final(F);
}

extern "C" void kernel_launch(void* const* d_in, const int* in_sizes, int n_in, void* d_out, int out_size, void* d_ws, size_t ws_size, hipStream_t stream) {
    static int grid = 0;
    if (grid == 0) {
        if (n_in != 20 || out_size != NTOK * DM || ws_size < WS_END) { fprintf(stderr, "kernel_launch: unexpected shapes (n_in %d, out %d, ws %zu); nothing launched\n", n_in, out_size, ws_size); grid = -1; return; }
        int dev = 0, cus = 0;
        if (hipGetDevice(&dev) != hipSuccess || hipDeviceGetAttribute(&cus, hipDeviceAttributeMultiprocessorCount, dev) != hipSuccess) { grid = -1; return; }
        if (hipFuncSetAttribute((const void*)mk_fwd, hipFuncAttributeMaxDynamicSharedMemorySize, LDS_BYTES) != hipSuccess) { fprintf(stderr, "kernel_launch: hipFuncSetAttribute failed\n"); grid = -1; return; }
        (void)hipGetLastError();
        grid = cus;
    }
    if (grid < 0) return;
    if (hipMemsetAsync((char*)d_ws + WS_CTL, 0, CTL_ZERO_BYTES, stream) != hipSuccess) { fprintf(stderr, "kernel_launch: memset failed\n"); return; }
    Args a{};
    for (int i = 0; i < 20; ++i) a.in[i] = (const float*)d_in[i];
    a.out = (float*)d_out; a.ws = (unsigned char*)d_ws;
    hipLaunchKernelGGL(mk_fwd, dim3(grid), dim3(NWAVES * 64), LDS_BYTES, stream, a);
}
```

```cpp
#include <hip/hip_runtime.h>
#include <cstdio>
#include <cstdint>
namespace pg8 {
#define PG8_LAS __attribute__((address_space(3)))
typedef unsigned short bf16_t;
typedef short bf16x8 __attribute__((ext_vector_type(8)));
typedef float f32x4 __attribute__((ext_vector_type(4)));
typedef unsigned u32x4 __attribute__((ext_vector_type(4)));
constexpr int BM = 256, BK = 64, HALF = 128, HTB = HALF * BK * 2  , STAGE_BYTES = 8 * HTB, NXCD = 8, WGM = 8;

__host__ __device__ __forceinline__ int lds_byte(int r, int c) { const int st = (r >> 4) * 2 + (c >> 5), rr = r & 15, cc = c & 31, ob = rr * 64 + cc * 2; return st * 1024 + (ob ^ (((ob >> 9) & 1) << 5)); }
__host__ __device__ __forceinline__ void stage_rc(int b, int& R, int& C) { const int st = b / 1024, sb = b % 1024, swz = sb ^ (((sb >> 9) & 1) << 5); R = (st >> 1) * 16 + swz / 64; C = (st & 1) * 32 + (swz % 64) / 2; }
__host__ __device__ __forceinline__ int perm32(int rho) { const int n = rho >> 4, i = rho & 15; return 8 * (i >> 2) + 4 * n + (i & 3); }

struct Unit { int pm, pn; };
struct Gemm { const bf16_t* A; const bf16_t* Bt; int M, N, K; };

struct StaticOrder {
    int nM, nN, nwg, G, c;
    __host__ __device__ void init(int M, int N, int G_, int c_) { nM = M / BM; nN = N / BM; nwg = nM * nN; G = G_; c = c_; }
    __host__ __device__ bool next(int i, Unit& u) const {
        const long L = (long)i * G + c; if (L >= nwg) return false;
        int wgid = (int)L; { const int q = nwg / NXCD, r = nwg % NXCD, xcd = wgid % NXCD, off = wgid / NXCD; wgid = (xcd < r ? xcd * (q + 1) : r * (q + 1) + (xcd - r) * q) + off; }
        const int nig = WGM * nN, gid = wgid / nig, fm = gid * WGM, gsz = (nM - fm) < WGM ? (nM - fm) : WGM;
        u.pm = fm + ((wgid % nig) % gsz); u.pn = (wgid % nig) / gsz; return true;
    }
    __device__ __forceinline__ void a_ready(const Unit&) const {}
    __device__ __forceinline__ void done(const Unit&) const {}
};

typedef __bf16 pg8_bf16x2 __attribute__((ext_vector_type(2)));
typedef float pg8_f2 __attribute__((ext_vector_type(2)));
__device__ __forceinline__ unsigned cvt_pk_bf16(float lo, float hi) { const pg8_f2 v = {lo, hi}; return __builtin_bit_cast(unsigned, __builtin_convertvector(v, pg8_bf16x2)); }
typedef float f32x2 __attribute__((ext_vector_type(2)));
__device__ __forceinline__ f32x2 gelu_pk(f32x2 v) {
    const f32x2 av = __builtin_elementwise_abs(v), d = av * 0.2316418882f + 1.0f;
    f32x2 t; t.x = __builtin_amdgcn_rcpf(d.x); t.y = __builtin_amdgcn_rcpf(d.y);
    f32x2 q = t * 0.5307027145f + (-0.7265760135f); q = q * t + 0.7107068705f; q = q * t + (-0.142248368f); q = q * t + 0.127414796f; q = q * t;
    const f32x2 s = (v * v) * (-0.72134752044f);
    f32x2 e; e.x = __builtin_amdgcn_exp2f(s.x); e.y = __builtin_amdgcn_exp2f(s.y);
    const f32x2 m = v * (q * e), r = v - m;
    f32x2 o; o.x = v.x < 0.f ? m.x : r.x; o.y = v.y < 0.f ? m.y : r.y; return o;
}

template <int ACT  > struct EpiBf16 {
    static constexpr bool PERM = true, AFTER_DRAIN = false; static_assert(ACT == 0 || ACT == 1, "EpiBf16: ACT is 0 (none) or 1 (gelu_pk)");
    bf16_t* O; int ldc; const float* bias; int split_cols; size_t split_stride; float scale0;
    __device__ __forceinline__ void operator()(const f32x4 (&acc)[2][2][4][2], const Unit& u, int wr, int wc, int fr, int fq) const {
        const int row0 = u.pm * BM + wr * 64 + fr; int colt = u.pn * BM; bf16_t* base = O;
        float sc = 1.f; if (split_cols) { const int t = colt / split_cols; base += (size_t)t * split_stride; colt -= t * split_cols; if (t == 0) sc = scale0; }
        const int col0 = colt + wc * 32 + 8 * fq, bcol0 = u.pn * BM + wc * 32 + 8 * fq;
        f32x4 bv[2][2];
#pragma unroll
        for (int bj = 0; bj < 2; ++bj)
#pragma unroll
            for (int n = 0; n < 2; ++n) bv[bj][n] = bias ? *(const f32x4*)(bias + bcol0 + bj * HALF + 4 * n) : (f32x4){0.f, 0.f, 0.f, 0.f};
#pragma unroll
        for (int ai = 0; ai < 2; ++ai)
#pragma unroll
            for (int m = 0; m < 4; ++m) { bf16_t* rowp = base + (size_t)(row0 + ai * HALF + m * 16) * ldc + col0;
#pragma unroll
                for (int bj = 0; bj < 2; ++bj) { f32x4 v0 = acc[ai][bj][m][0] + bv[bj][0], v1 = acc[ai][bj][m][1] + bv[bj][1];
                    if (ACT == 1) { f32x2 a = gelu_pk((f32x2){v0[0], v0[1]}), b = gelu_pk((f32x2){v0[2], v0[3]}), c = gelu_pk((f32x2){v1[0], v1[1]}), d = gelu_pk((f32x2){v1[2], v1[3]});
                        v0 = (f32x4){a.x, a.y, b.x, b.y}; v1 = (f32x4){c.x, c.y, d.x, d.y}; }
                    v0 = v0 * sc; v1 = v1 * sc; u32x4 w; w.x = cvt_pk_bf16(v0[0], v0[1]); w.y = cvt_pk_bf16(v0[2], v0[3]); w.z = cvt_pk_bf16(v1[0], v1[1]); w.w = cvt_pk_bf16(v1[2], v1[3]);
                    *(u32x4*)(rowp + bj * HALF) = w; } }
    }
};

template <class Epi, class Sched, bool ALIGN_EPI = false, bool SP2 = false>
__device__ __forceinline__ void gemm_phase(PG8_LAS unsigned char* lds, const Gemm g, const Sched& S, const Epi& E) {
    const int tid = threadIdx.x, wid = __builtin_amdgcn_readfirstlane(tid >> 6), lane = tid & 63, wr = wid >> 2, wc = wid & 3, fr = lane & 15, fq = lane >> 4;
    const int K = g.K, nt = K / BK;
    unsigned voffA[2], voffB[2];
#pragma unroll
    for (int i = 0; i < 2; ++i) { int R, C; stage_rc(tid * 16 + i * 8192, R, C); const int Rb = Epi::PERM ? ((R & ~31) + perm32(R & 31)) : R;
        voffA[i] = (unsigned)(R * K + C) * 2u; voffB[i] = (unsigned)(Rb * K + C) * 2u; }
    const size_t kstep = (size_t)(BK * 2);
    const size_t hstep = (size_t)HALF * K * 2;
    const size_t tstep = 2 * hstep;
    const unsigned ldsw = (unsigned)wid * 1024u;
    const int aoff = lds_byte(wr * 64 + fr, fq * 8), boff = lds_byte(wc * 32 + fr, fq * 8);
#define PG8_SA(b, h) (((b) * 2 + (h)) * HTB)
#define PG8_SB(b, h) ((4 + (b) * 2 + (h)) * HTB)
#define PG8_STAGE(bufoff, gbase, voff) do { _Pragma("unroll") for (int _i = 0; _i < 2; ++_i) \
        __builtin_amdgcn_global_load_lds((const unsigned*)((const char*)(gbase) + (voff)[_i]), (PG8_LAS unsigned*)(lds + (bufoff) + ldsw + _i * 8192), 16, 0, 0); } while (0)
#define PG8_LDA(dst, b, h) do { _Pragma("unroll") for (int m = 0; m < 4; ++m) _Pragma("unroll") for (int k = 0; k < 2; ++k) dst[m][k] = *(const PG8_LAS bf16x8*)(lds + PG8_SA(b, h) + aoff + m * 2048 + k * 1024); } while (0)
#define PG8_LDB(dst, b, h) do { _Pragma("unroll") for (int n = 0; n < 2; ++n) _Pragma("unroll") for (int k = 0; k < 2; ++k) dst[n][k] = *(const PG8_LAS bf16x8*)(lds + PG8_SB(b, h) + boff + n * 2048 + k * 1024); } while (0)
#define PG8_MMA(ai, bj, At, Bt) do { __builtin_amdgcn_s_setprio(1); _Pragma("unroll") for (int m = 0; m < 4; ++m) _Pragma("unroll") for (int n = 0; n < 2; ++n) _Pragma("unroll") for (int k = 0; k < 2; ++k) \
        acc[ai][bj][m][n] = __builtin_amdgcn_mfma_f32_16x16x32_bf16(Bt[n][k], At[m][k], acc[ai][bj][m][n], 0, 0, 0); __builtin_amdgcn_s_setprio(0); } while (0)
#define PG8_WAIT_V(n) asm volatile("s_waitcnt vmcnt(" #n ")" ::: "memory")
#define PG8_WAIT_L(n) asm volatile("s_waitcnt lgkmcnt(" #n ")" ::: "memory")
#define PG8_BAR __builtin_amdgcn_s_barrier()
#define PG8_SCHED __builtin_amdgcn_sched_barrier(0)
    Unit cur, nxt; int ui = 0;
    if (!S.next(0, cur)) return;
    f32x4 acc[2][2][4][2];
#pragma unroll
    for (int a = 0; a < 2; ++a)
#pragma unroll
        for (int b = 0; b < 2; ++b)
#pragma unroll
            for (int m = 0; m < 4; ++m)
#pragma unroll
                for (int n = 0; n < 2; ++n) acc[a][b][m][n] = (f32x4){0.f, 0.f, 0.f, 0.f};
    bf16x8 At[4][2], B0[2][2], B1[2][2];
    const char* cA = (const char*)g.A + (size_t)cur.pm * tstep; const char* cB = (const char*)g.Bt + (size_t)cur.pn * tstep;
    S.a_ready(cur);
    if constexpr (SP2) {
        PG8_STAGE(PG8_SB(0, 0), cB, voffB); PG8_STAGE(PG8_SB(0, 1), cB + hstep, voffB); PG8_STAGE(PG8_SA(0, 0), cA, voffA); PG8_STAGE(PG8_SA(0, 1), cA + hstep, voffA);
        if (wr == 1) PG8_BAR;
        PG8_WAIT_V(2); PG8_BAR;
        PG8_STAGE(PG8_SB(1, 0), cB + kstep, voffB); PG8_STAGE(PG8_SA(1, 0), cA + kstep, voffA); PG8_STAGE(PG8_SB(1, 1), cB + hstep + kstep, voffB);
        PG8_WAIT_V(6); PG8_BAR;
    } else {
        PG8_STAGE(PG8_SB(0, 0), cB, voffB); PG8_STAGE(PG8_SA(0, 0), cA, voffA); PG8_STAGE(PG8_SB(0, 1), cB + hstep, voffB); PG8_STAGE(PG8_SA(0, 1), cA + hstep, voffA);
        if (wr == 1) PG8_BAR;
        PG8_WAIT_V(4); PG8_BAR;
        PG8_STAGE(PG8_SB(1, 0), cB + kstep, voffB); PG8_STAGE(PG8_SA(1, 0), cA + kstep, voffA); PG8_STAGE(PG8_SB(1, 1), cB + hstep + kstep, voffB);
        PG8_WAIT_V(6); PG8_BAR;
    }
    for (;;) {
        const bool has_next = S.next(ui + 1, nxt);
        const char* nA = has_next ? (const char*)g.A + (size_t)nxt.pm * tstep : cA; const char* nB = has_next ? (const char*)g.Bt + (size_t)nxt.pn * tstep : cB;
        for (int t = 0; t < nt; t += 2) {
            const bool last = (t == nt - 2);
            const char* a1 = cA + (size_t)(t + 1) * kstep;
            const char* a2 = last ? nA : cA + (size_t)(t + 2) * kstep; const char* b2 = last ? nB : cB + (size_t)(t + 2) * kstep;
            const char* a3 = a2 + kstep; const char* b3 = b2 + kstep;
            if (last && has_next) S.a_ready(nxt);
            if constexpr (SP2) {
            PG8_LDB(B0, 0, 0); PG8_LDB(B1, 0, 1); PG8_SCHED; PG8_LDA(At, 0, 0); PG8_STAGE(PG8_SA(1, 1), a1 + hstep, voffA);
            PG8_WAIT_V(8); PG8_WAIT_L(0); PG8_BAR; PG8_MMA(0, 0, At, B0); PG8_MMA(0, 1, At, B1); PG8_BAR; PG8_SCHED;
            PG8_LDA(At, 0, 1); PG8_STAGE(PG8_SB(0, 0), b2, voffB); PG8_STAGE(PG8_SB(0, 1), b2 + hstep, voffB); PG8_STAGE(PG8_SA(0, 0), a2, voffA);
            PG8_WAIT_V(8); PG8_WAIT_L(0); PG8_BAR; PG8_MMA(1, 0, At, B0); PG8_MMA(1, 1, At, B1); PG8_BAR; PG8_SCHED;
            PG8_LDB(B0, 1, 0); PG8_LDB(B1, 1, 1); PG8_SCHED; PG8_LDA(At, 1, 0); PG8_STAGE(PG8_SA(0, 1), a2 + hstep, voffA);
            PG8_WAIT_V(8); PG8_WAIT_L(0); PG8_BAR; PG8_MMA(0, 0, At, B0); PG8_MMA(0, 1, At, B1); PG8_BAR; PG8_SCHED;
            PG8_LDA(At, 1, 1); PG8_STAGE(PG8_SB(1, 0), b3, voffB); PG8_STAGE(PG8_SB(1, 1), b3 + hstep, voffB); PG8_STAGE(PG8_SA(1, 0), a3, voffA);
            PG8_WAIT_V(8); PG8_WAIT_L(0); PG8_BAR; PG8_MMA(1, 0, At, B0); PG8_MMA(1, 1, At, B1); PG8_BAR; PG8_SCHED;
            } else {
            PG8_LDB(B0, 0, 0); PG8_SCHED; PG8_LDA(At, 0, 0); PG8_STAGE(PG8_SA(1, 1), a1 + hstep, voffA);
            PG8_WAIT_L(8); PG8_BAR; PG8_WAIT_L(0); PG8_MMA(0, 0, At, B0); PG8_BAR; PG8_SCHED;
            PG8_LDB(B1, 0, 1); PG8_STAGE(PG8_SB(0, 0), b2, voffB);
            PG8_BAR; PG8_WAIT_L(0); PG8_MMA(0, 1, At, B1); PG8_BAR;
            PG8_LDA(At, 0, 1); PG8_STAGE(PG8_SA(0, 0), a2, voffA);
            PG8_BAR; PG8_WAIT_L(0); PG8_MMA(1, 0, At, B0); PG8_BAR; PG8_SCHED;
            PG8_STAGE(PG8_SB(0, 1), b2 + hstep, voffB);
            PG8_WAIT_V(6); PG8_BAR; PG8_MMA(1, 1, At, B1); PG8_BAR;
            PG8_LDB(B0, 1, 0); PG8_SCHED; PG8_LDA(At, 1, 0); PG8_STAGE(PG8_SA(0, 1), a2 + hstep, voffA);
            PG8_WAIT_L(8); PG8_BAR; PG8_WAIT_L(0); PG8_MMA(0, 0, At, B0); PG8_BAR; PG8_SCHED;
            PG8_LDB(B1, 1, 1); PG8_STAGE(PG8_SB(1, 0), b3, voffB);
            PG8_BAR; PG8_WAIT_L(0); PG8_MMA(0, 1, At, B1); PG8_BAR;
            PG8_LDA(At, 1, 1); PG8_STAGE(PG8_SA(1, 0), a3, voffA);
            PG8_BAR; PG8_WAIT_L(0); PG8_MMA(1, 0, At, B0); PG8_BAR; PG8_SCHED;
            PG8_STAGE(PG8_SB(1, 1), b3 + hstep, voffB);
            PG8_WAIT_V(6); PG8_BAR; PG8_MMA(1, 1, At, B1); PG8_BAR;
            }
        }
        if constexpr (ALIGN_EPI) { if (wr == 0) PG8_BAR; }
        if constexpr (!Epi::AFTER_DRAIN) { E(acc, cur, wr, wc, fr, fq); S.done(cur); }
        if (!has_next) break;
#pragma unroll
        for (int a = 0; a < 2; ++a)
#pragma unroll
            for (int b = 0; b < 2; ++b)
#pragma unroll
                for (int m = 0; m < 4; ++m)
#pragma unroll
                    for (int n = 0; n < 2; ++n) acc[a][b][m][n] = (f32x4){0.f, 0.f, 0.f, 0.f};
        cur = nxt; cA = nA; cB = nB; ++ui;
        if constexpr (ALIGN_EPI) { if (wr == 1) PG8_BAR; }
    }
    PG8_WAIT_V(0);
    if constexpr (!ALIGN_EPI) { if (wr == 0) PG8_BAR; }
    PG8_BAR;
    if constexpr (Epi::AFTER_DRAIN) { E.fused(acc, cur, wr, wc, fr, fq, lds, wid, lane); S.done(cur); }
#undef PG8_SA
#undef PG8_SB
#undef PG8_STAGE
#undef PG8_LDA
#undef PG8_LDB
#undef PG8_MMA
#undef PG8_WAIT_V
#undef PG8_WAIT_L
#undef PG8_BAR
#undef PG8_SCHED
}
}
#define PG8_SP2 true
#define PG8_ALIGN true
constexpr int NWAVES = 8;
constexpr int BATCH = 8, SEQ = 2048, DM = 1024, CTXL = 256, NTOK = BATCH * SEQ, NCTX = BATCH * CTXL, NROWS = NTOK + NCTX;
constexpr int C_ALR = 1536, C_BQ = 1568, C_BG = 3104, C_BBETA = 3616, C_MG = 3632, D_IN = 5680;
constexpr int NIN = 5888;
constexpr int NSM = 48;
constexpr float EPSV = 1e-6f;
constexpr size_t MiB = 1u << 20;
constexpr size_t WS_CTL = 0, CTL_ZERO_BYTES = 1 * MiB;
constexpr int CW_BAR = 4096;
constexpr size_t WS_MOD = 64 * 1024, WS_ROWSS = 256 * 1024;
constexpr size_t WS_WTIN = 2 * MiB, WS_WTGA = 14 * MiB, WS_WTGD = 15 * MiB, WS_WTO = 16 * MiB;
constexpr size_t WS_H = 18 * MiB, WS_AQ = 54 * MiB, WS_AK = 62 * MiB, WS_PRE = 71 * MiB, WS_SM = 125 * MiB, WS_VTA = 129 * MiB;
constexpr size_t WS_KIMG = 147 * MiB, WS_KTIMG = 165 * MiB, WS_VT = 183 * MiB, WS_TBIMG = 201 * MiB, WS_KDTIMG = 219 * MiB, WS_SCAL = 237 * MiB, WS_EBL = 239 * MiB + 512 * 1024;
constexpr size_t DO_QIMG = 0, DO_AQKIMG = 16 * MiB, DO_QEIMG = 32 * MiB, DO_ATTIMG = 48 * MiB;
#ifndef DBG_NAIVE_GDN
#define DBG_NAIVE_GDN 0
#endif
#ifndef DBG_NAIVE_GLA
#define DBG_NAIVE_GLA 0
#endif
#if DBG_NAIVE_GLA
constexpr size_t WS_OAF = 219 * MiB, WS_OAB = 240 * MiB;
#else
constexpr size_t WS_OAF = 54 * MiB, WS_OAB = 70 * MiB;
#endif
constexpr size_t WS_OBF = 86 * MiB, WS_OBB = 102 * MiB, WS_AG = 118 * MiB, WS_BG = 134 * MiB, WS_YA = 150 * MiB, WS_YB = 166 * MiB;
constexpr size_t WS_TMP = 182 * MiB, WS_MERGED = 18 * MiB, WS_END = 256 * MiB;
constexpr size_t WS_POST = WS_KIMG, DO_DBGAV = 32 * MiB;
constexpr int LDS_BYTES = 147456 + 256;
constexpr int MISC_OFF = 147456;

#define GAS __attribute__((address_space(1)))
#define LAS __attribute__((address_space(3)))
typedef unsigned short bf16;
typedef unsigned v4u __attribute__((ext_vector_type(4)));
typedef unsigned v2u __attribute__((ext_vector_type(2)));
typedef float f32x4 __attribute__((ext_vector_type(4)));
#define LDS_WAIT() asm volatile("s_waitcnt lgkmcnt(0)" ::: "memory")
#define VM_WAIT() asm volatile("s_waitcnt vmcnt(0)" ::: "memory")
__device__ __forceinline__ unsigned f2bf(float f) { unsigned u = __builtin_bit_cast(unsigned, f); return (u + 0x7fffu + ((u >> 16) & 1u)) >> 16; }
__device__ __forceinline__ unsigned pk2(float lo, float hi) { return f2bf(lo) | (f2bf(hi) << 16); }
__device__ __forceinline__ float bflo(unsigned w) { return __builtin_bit_cast(float, w << 16); }
__device__ __forceinline__ float bfhi(unsigned w) { return __builtin_bit_cast(float, w & 0xffff0000u); }
__device__ __forceinline__ float bf2f(bf16 b) { return __builtin_bit_cast(float, ((unsigned)b) << 16); }
__device__ __forceinline__ float fsigm(float x) { return __builtin_amdgcn_rcpf(1.f + __expf(-x)); }
__device__ __forceinline__ float fsilu(float x) { return x * fsigm(x); }
__device__ __forceinline__ float softplusf_(float x) { return fmaxf(x, 0.f) + log1pf(expf(-fabsf(x))); }
__device__ __forceinline__ float logsigf_(float x) { return fminf(x, 0.f) - log1pf(expf(-fabsf(x))); }
__device__ __forceinline__ void unpack8(v4u w, float (&v)[8]) { v[0] = bflo(w.x); v[1] = bfhi(w.x); v[2] = bflo(w.y); v[3] = bfhi(w.y); v[4] = bflo(w.z); v[5] = bfhi(w.z); v[6] = bflo(w.w); v[7] = bfhi(w.w); }
__device__ __forceinline__ v4u pack8(const float (&v)[8]) { v4u w; w.x = pk2(v[0], v[1]); w.y = pk2(v[2], v[3]); w.z = pk2(v[4], v[5]); w.w = pk2(v[6], v[7]); return w; }
__device__ __forceinline__ float wave_sum(float v) {
#pragma unroll
    for (int o = 1; o < 64; o <<= 1) v += __shfl_xor(v, o);
    return v;
}
__device__ __forceinline__ float grp16_sum(float v) {
#pragma unroll
    for (int o = 1; o < 16; o <<= 1) v += __shfl_xor(v, o);
    return v;
}

#define XB_TMO      128
#define XB_XCNT(j)  (256  + 64 * (j))
#define XB_XSUB(j)  (1280 + 64 * (j))
#define XB_XGEN(j)  (2304 + 64 * (j))
#define XB_TOP      3328
#define XB_TOPGEN   3392
#define XCD_BAR_WORDS 3456
#define XB_SPIN_CAP (1u << 22)
__device__ __forceinline__ unsigned xb_ld(unsigned* p)              { return __hip_atomic_load(p, __ATOMIC_RELAXED, __HIP_MEMORY_SCOPE_AGENT); }
__device__ __forceinline__ unsigned xb_add(unsigned* p, unsigned v) { return __hip_atomic_fetch_add(p, v, __ATOMIC_RELAXED, __HIP_MEMORY_SCOPE_AGENT); }
__device__ __forceinline__ unsigned xb_xcc_id() { return (unsigned)__builtin_amdgcn_s_getreg((3 << 11) | 20) & 0xFu; }
#define XB_SPIN(cond, bar) do { unsigned _sp = 0; while (cond) { __builtin_amdgcn_s_sleep(1); \
    if ((++_sp & 255u) == 0u) { if (xb_ld(&(bar)[XB_TMO])) break; if (_sp > XB_SPIN_CAP) { atomicAdd(&(bar)[XB_TMO], 1u); break; } } } } while (0)
struct XcdBarrier { unsigned* bar; unsigned x; volatile LAS unsigned* st; };
__device__ __forceinline__ XcdBarrier xcd_barrier_post(unsigned* bar, volatile LAS unsigned* st) {
    XcdBarrier b; b.bar = bar; b.x = xb_xcc_id(); b.st = st;
    if (threadIdx.x == 0) (void)xb_add(&bar[XB_XCNT(b.x)], 1u);
    return b;
}
__device__ __forceinline__ void xcd_barrier_complete(unsigned* bar, unsigned x, unsigned& nloc, unsigned& nx) {
    const unsigned G = gridDim.x * gridDim.y * gridDim.z;
    unsigned sum, cnt, mine, sp = 0u;
    for (;;) {
        sum = 0u; cnt = 0u; mine = 0u;
#pragma unroll
        for (unsigned j = 0; j < 16; ++j) { const unsigned c = xb_ld(&bar[XB_XCNT(j)]); sum += c; cnt += (c > 0u) ? 1u : 0u; mine = (j == x) ? c : mine; }
        if (sum == G) break;
        __builtin_amdgcn_s_sleep(1);
        if ((++sp & 255u) == 0u) { if (xb_ld(&bar[XB_TMO])) break; if (sp > XB_SPIN_CAP) { atomicAdd(&bar[XB_TMO], 1u); break; } }
    }
    nloc = mine > 0u ? mine : 1u; nx = cnt > 0u ? cnt : 1u;
}
__device__ __forceinline__ void xcd_barrier(const XcdBarrier& b) {
    asm volatile("s_waitcnt vmcnt(0)" ::: "memory");
    __syncthreads();
    if (threadIdx.x == 0) {
        unsigned* bar = b.bar;
        __builtin_amdgcn_s_waitcnt(0);
        unsigned nloc = b.st[0], nx = b.st[1];
        if (nloc == 0u) { xcd_barrier_complete(bar, b.x, nloc, nx); b.st[0] = nloc; b.st[1] = nx; }
        const unsigned old = xb_add(&bar[XB_XSUB(b.x)], 1u);
        const unsigned gen = old / nloc;
        if (old + 1u == (gen + 1u) * nloc) {
            __builtin_amdgcn_fence(__ATOMIC_RELEASE, "agent");
            asm volatile("s_waitcnt vmcnt(0)" ::: "memory");
            const unsigned og = xb_add(&bar[XB_TOP], 1u);
            const unsigned tg = og / nx;
            if (og + 1u == (tg + 1u) * nx) xb_add(&bar[XB_TOPGEN], 1u);
            else XB_SPIN(xb_ld(&bar[XB_TOPGEN]) == tg, bar);
            __builtin_amdgcn_fence(__ATOMIC_ACQUIRE, "agent");
            xb_add(&bar[XB_XGEN(b.x)], 1u);
            asm volatile("s_waitcnt vmcnt(0)" ::: "memory");
        } else {
            XB_SPIN(xb_ld(&bar[XB_XGEN(b.x)]) == gen, bar);
            __builtin_amdgcn_fence(__ATOMIC_ACQUIRE, "agent");
            asm volatile("s_waitcnt vmcnt(0)" ::: "memory");
        }
    }
    __syncthreads();
}

namespace pg8 {
struct EpiIn {
    static constexpr bool PERM = true, AFTER_DRAIN = false;
    unsigned char* ws; bf16* GATES; float* SM; const float* b_gate; int pnoff;
    __device__ __forceinline__ void operator()(const f32x4 (&acc)[2][2][4][2], const Unit& u, int wr, int wc, int fr, int fq) const {
        const int pn = u.pn + pnoff, row0 = u.pm * BM + wr * 64 + fr; const bool lat = u.pm < NTOK / BM;
        if (pn == 10) {
            if (wc > 1 || (wc == 1 && fq >= 2)) return;
            const int c0 = wc * 32 + 8 * fq;
#pragma unroll
            for (int ai = 0; ai < 2; ++ai)
#pragma unroll
                for (int m = 0; m < 4; ++m) { float* rp = SM + (size_t)(row0 + ai * HALF + m * 16) * NSM + c0;
                    *(f32x4*)rp = acc[ai][0][m][0]; *(f32x4*)(rp + 4) = acc[ai][0][m][1]; }
            return;
        }
        if (pn == 2 || pn == 3) {
            bf16* VTA = (bf16*)(ws + WS_VTA);
#if DBG_NAIVE_GLA
            bf16* AVR = GATES + DO_DBGAV / 2;
#endif
#pragma unroll
            for (int ai = 0; ai < 2; ++ai)
#pragma unroll
                for (int m = 0; m < 4; ++m) { const int row = row0 + ai * HALF + m * 16; int b, cid;
                    if (row < NTOK) { b = row >> 11; cid = 4 + ((row & 2047) >> 6); } else { const int rr = row - NTOK; b = rr >> 8; cid = (rr & 255) >> 6; }
                    const int pos = row & 63;
#pragma unroll
                    for (int bj = 0; bj < 2; ++bj) { const int h = (pn - 2) * 2 + bj; bf16* dst = VTA + ((size_t)((b * 4 + h) * 36 + cid) * 128 + wc * 32 + 8 * fq) * 64 + pos;
#pragma unroll
                        for (int n = 0; n < 2; ++n)
#pragma unroll
                            for (int j = 0; j < 4; ++j) dst[(4 * n + j) * 64] = (bf16)(cvt_pk_bf16(acc[ai][bj][m][n][j], 0.f) & 0xffffu);
#if DBG_NAIVE_GLA
                        u32x4 w; w.x = cvt_pk_bf16(acc[ai][bj][m][0][0], acc[ai][bj][m][0][1]); w.y = cvt_pk_bf16(acc[ai][bj][m][0][2], acc[ai][bj][m][0][3]); w.z = cvt_pk_bf16(acc[ai][bj][m][1][0], acc[ai][bj][m][1][1]); w.w = cvt_pk_bf16(acc[ai][bj][m][1][2], acc[ai][bj][m][1][3]);
                        *(u32x4*)(AVR + (size_t)row * 512 + (pn - 2) * 256 + bj * HALF + wc * 32 + 8 * fq) = w;
#endif
                    } }
            return;
        }
        size_t boff; int ld, cb, act = 0; float sc = 1.f; bool latonly = false;
        if (pn == 0) { boff = WS_AQ; ld = 256; cb = 0; sc = 0.125f; latonly = true; }
        else if (pn == 1) { boff = WS_AK; ld = 256; cb = 0; }
        else if (pn < 10) { boff = WS_PRE; ld = 1536; cb = (pn - 4) * 256; }
        else if (pn < 13) { boff = WS_AG; ld = 512; cb = (pn - 11) * 256; act = 1; latonly = true; }
        else if (pn < 15) { boff = WS_BG; ld = 512; cb = (pn - 13) * 256; act = 1; latonly = true; }
        else { boff = 0; ld = 2048; cb = (pn - 15) * 256; act = 2; latonly = true; }
        bf16* base = (pn >= 15) ? GATES : (bf16*)(ws + boff);
        if (latonly && !lat) return;
        const int col0 = cb + wc * 32 + 8 * fq;
#pragma unroll
        for (int ai = 0; ai < 2; ++ai)
#pragma unroll
            for (int m = 0; m < 4; ++m) { bf16* rowp = base + (size_t)(row0 + ai * HALF + m * 16) * ld + col0;
#pragma unroll
                for (int bj = 0; bj < 2; ++bj) { f32x4 v0 = acc[ai][bj][m][0], v1 = acc[ai][bj][m][1];
                    if (act == 1) {
#pragma unroll
                        for (int j = 0; j < 4; ++j) { v0[j] = fsilu(v0[j]); v1[j] = fsilu(v1[j]); } }
                    else if (act == 2) { const f32x4 b0 = *(const f32x4*)(b_gate + col0 + bj * HALF), b1 = *(const f32x4*)(b_gate + col0 + bj * HALF + 4);
#pragma unroll
                        for (int j = 0; j < 4; ++j) { v0[j] = fsigm(v0[j] + b0[j]); v1[j] = fsigm(v1[j] + b1[j]); } }
                    else { v0 = v0 * sc; v1 = v1 * sc; }
                    u32x4 w; w.x = cvt_pk_bf16(v0[0], v0[1]); w.y = cvt_pk_bf16(v0[2], v0[3]); w.z = cvt_pk_bf16(v1[0], v1[1]); w.w = cvt_pk_bf16(v1[2], v1[3]);
                    *(u32x4*)(rowp + bj * HALF) = w; } }
    }
};
struct OrderA {
    int G, c;
    __device__ void init(int G_, int c_) { G = G_; c = c_; }
    __device__ bool next(int i, Unit& u) const {
        const int L = i * G + c; if (L >= 768) return false;
        if (L < 704) { int wgid = L; { const int q = 704 / NXCD, xcd = wgid % NXCD, off = wgid / NXCD; wgid = xcd * q + off; }
            const int nN = 11, nM = 64, nig = WGM * nN, gid = wgid / nig, fm = gid * WGM, gsz = (nM - fm) < WGM ? (nM - fm) : WGM;
            u.pm = fm + ((wgid % nig) % gsz); u.pn = (wgid % nig) / gsz; return true; }
        const int l2 = L - 704, idx = l2 >> 3; u.pm = 64 + (l2 & 7); u.pn = idx < 3 ? idx + 1 : idx + 3; return true;
    }
    __device__ __forceinline__ void a_ready(const Unit&) const {}
    __device__ __forceinline__ void done(const Unit&) const {}
};
struct EpiGa {
    static constexpr bool PERM = true, AFTER_DRAIN = false;
    const bf16* GATES; float* TMP;
    __device__ __forceinline__ void operator()(const f32x4 (&acc)[2][2][4][2], const Unit& u, int wr, int wc, int fr, int fq) const {
        const int row0 = u.pm * BM + wr * 64 + fr, col0 = u.pn * BM + wc * 32 + 8 * fq;
#pragma unroll
        for (int ai = 0; ai < 2; ++ai)
#pragma unroll
            for (int m = 0; m < 4; ++m) { const size_t r = (size_t)(row0 + ai * HALF + m * 16);
#pragma unroll
                for (int bj = 0; bj < 2; ++bj) { const u32x4 g = *(const u32x4*)(GATES + r * 2048 + col0 + bj * HALF); float gv[8]; unpack8((v4u)g, gv);
                    f32x4 v0 = acc[ai][bj][m][0], v1 = acc[ai][bj][m][1];
#pragma unroll
                    for (int j = 0; j < 4; ++j) { v0[j] *= gv[j]; v1[j] *= gv[4 + j]; }
                    float* tp = TMP + r * 1024 + col0 + bj * HALF; *(f32x4*)tp = v0; *(f32x4*)(tp + 4) = v1; } }
    }
};
struct EpiGb {
    static constexpr bool PERM = true, AFTER_DRAIN = false;
    const bf16* GATES; const float* TMP; bf16* MERGED;
    __device__ __forceinline__ void operator()(const f32x4 (&acc)[2][2][4][2], const Unit& u, int wr, int wc, int fr, int fq) const {
        const int row0 = u.pm * BM + wr * 64 + fr, col0 = u.pn * BM + wc * 32 + 8 * fq;
#pragma unroll
        for (int ai = 0; ai < 2; ++ai)
#pragma unroll
            for (int m = 0; m < 4; ++m) { const size_t r = (size_t)(row0 + ai * HALF + m * 16);
#pragma unroll
                for (int bj = 0; bj < 2; ++bj) { const u32x4 g = *(const u32x4*)(GATES + r * 2048 + 1024 + col0 + bj * HALF); float gv[8]; unpack8((v4u)g, gv);
                    const float* tp = TMP + r * 1024 + col0 + bj * HALF; f32x4 v0 = *(const f32x4*)tp, v1 = *(const f32x4*)(tp + 4);
#pragma unroll
                    for (int j = 0; j < 4; ++j) { v0[j] += gv[j] * acc[ai][bj][m][0][j]; v1[j] += gv[4 + j] * acc[ai][bj][m][1][j]; }
                    u32x4 w; w.x = cvt_pk_bf16(v0[0], v0[1]); w.y = cvt_pk_bf16(v0[2], v0[3]); w.z = cvt_pk_bf16(v1[0], v1[1]); w.w = cvt_pk_bf16(v1[2], v1[3]);
                    *(u32x4*)(MERGED + r * 1024 + col0 + bj * HALF) = w; } }
    }
};
struct EpiOut {
    static constexpr bool PERM = true, AFTER_DRAIN = false;
    const float* x; const float* MOD; float* out; float* ROWSS;
    __device__ __forceinline__ void operator()(const f32x4 (&acc)[2][2][4][2], const Unit& u, int wr, int wc, int fr, int fq) const {
        const int row0 = u.pm * BM + wr * 64 + fr, col0 = u.pn * BM + wc * 32 + 8 * fq;
        const float* gt = MOD + (size_t)(u.pm * BM / SEQ) * 3072 + 2048 + col0;
        f32x4 g[2][2];
#pragma unroll
        for (int bj = 0; bj < 2; ++bj) { g[bj][0] = *(const f32x4*)(gt + bj * HALF); g[bj][1] = *(const f32x4*)(gt + bj * HALF + 4); }
#pragma unroll
        for (int ai = 0; ai < 2; ++ai)
#pragma unroll
            for (int m = 0; m < 4; ++m) { const size_t r = (size_t)(row0 + ai * HALF + m * 16); float ss = 0.f;
#pragma unroll
                for (int bj = 0; bj < 2; ++bj) { const float* xp = x + r * 1024 + col0 + bj * HALF; float* op = out + r * 1024 + col0 + bj * HALF;
                    f32x4 y0 = *(const f32x4*)xp + g[bj][0] * acc[ai][bj][m][0], y1 = *(const f32x4*)(xp + 4) + g[bj][1] * acc[ai][bj][m][1];
                    *(f32x4*)op = y0; *(f32x4*)(op + 4) = y1;
                    ss += (y0[0] * y0[0] + y0[1] * y0[1]) + (y0[2] * y0[2] + y0[3] * y0[3]) + (y1[0] * y1[0] + y1[1] * y1[1]) + (y1[2] * y1[2] + y1[3] * y1[3]); }
                ss += __shfl_xor(ss, 16); ss += __shfl_xor(ss, 32);
                if (fq == 0) atomicAdd(ROWSS + r, ss); }
    }
};
}

struct Args { const float* in[20]; float* out; unsigned char* ws; };
struct Frame {
    LAS unsigned char* lds; volatile LAS unsigned* MISC; unsigned* ctl;
    int tid, lane, wave, vcu, G, gw, NGW;
    const float *x, *c, *ctx, *c_ctx, *w_mod, *b_mod, *norm_g, *w_in, *gla_up, *gla_ub, *gla_onorm, *gdn_conv, *gdn_a_log, *gdn_dt_bias, *gdn_onorm, *w_gla_out, *w_gdn_out, *b_gate, *w_o, *final_g;
    float* out; unsigned char* ws;
};

__device__ __forceinline__ int in_src_col(int d) {
    if (d < 1024) return d;
    if (d < 2560) return C_BQ + (d - 1024);
    if (d < 2592) return C_ALR + (d - 2560);
    if (d < 2608) return C_BBETA + (d - 2592);
    if (d < 2816) return -1;
    if (d < 3328) return 1024 + (d - 2816);
    if (d < 3840) return C_BG + (d - 3328);
    return C_MG + (d - 3840);
}
template <bool MAP>
__device__ __forceinline__ void p0_transpose_item(const float* W, int K, int ldw, int nblk, bf16* WT, LAS float* scr, int item, int lane) {
    const int kb = item / nblk, nb = item % nblk, k0 = 64 * kb, n0 = 32 * nb;
    const int sc = MAP ? in_src_col(n0 + (lane & 31)) : n0 + (lane & 31);
#pragma unroll 8
    for (int i = 0; i < 32; ++i) { const int kk = 2 * i + (lane >> 5); scr[kk * 33 + (lane & 31)] = sc >= 0 ? W[(size_t)(k0 + kk) * ldw + sc] : 0.f; }
    LDS_WAIT(); asm volatile("" ::: "memory");
    const int c = lane & 7;
#pragma unroll
    for (int j = 0; j < 4; ++j) { const int n = (lane >> 3) + 8 * j; const LAS float* s = scr + (8 * c) * 33 + n;
        v4u o; o.x = pk2(s[0 * 33], s[1 * 33]); o.y = pk2(s[2 * 33], s[3 * 33]); o.z = pk2(s[4 * 33], s[5 * 33]); o.w = pk2(s[6 * 33], s[7 * 33]);
        *(GAS v4u*)(WT + (size_t)(n0 + n) * K + k0 + 8 * c) = o; }
    LDS_WAIT(); asm volatile("" ::: "memory");
}
__device__ __forceinline__ void p0_prologue(Frame& F) {
    LAS float* tab = (LAS float*)(F.lds + 69632);
    for (int i = F.tid; i < 9 * 1024; i += NWAVES * 64) { const int r = i >> 10, k = i & 1023; const float v = r < 8 ? F.c[r * 1024 + k] : F.c_ctx[k]; tab[i] = v / (1.f + __expf(-v)); }
    __syncthreads();
    float* MOD = (float*)(F.ws + WS_MOD);
    for (int it = F.gw; it < 768; it += F.NGW) {
        const int cb = it % 48, ks = it / 48, j = cb * 64 + F.lane; float acc[9];
#pragma unroll
        for (int r = 0; r < 9; ++r) acc[r] = 0.f;
#pragma unroll 8
        for (int kk = 0; kk < 64; ++kk) { const int k = ks * 64 + kk; const float w = F.w_mod[(size_t)k * 3072 + j];
#pragma unroll
            for (int r = 0; r < 9; ++r) acc[r] += tab[r * 1024 + k] * w; }
        const float bias = ks == 0 ? F.b_mod[j] : 0.f;
#pragma unroll
        for (int r = 0; r < 9; ++r) atomicAdd(MOD + r * 3072 + j, acc[r] + bias);
    }
    LAS float* scr = (LAS float*)(F.lds + F.wave * 8704);
    constexpr int I_IN = 16 * (NIN / 32), I_G = 8 * 32, I_O = 16 * 32, NITEMS = I_IN + 2 * I_G + I_O;
    for (int it = F.gw; it < NITEMS; it += F.NGW) {
        int r = it;
        if (r < I_IN) { p0_transpose_item<true>(F.w_in, 1024, D_IN, NIN / 32, (bf16*)(F.ws + WS_WTIN), scr, r, F.lane); continue; } r -= I_IN;
        if (r < I_G) { p0_transpose_item<false>(F.w_gla_out, 512, 1024, 32, (bf16*)(F.ws + WS_WTGA), scr, r, F.lane); continue; } r -= I_G;
        if (r < I_G) { p0_transpose_item<false>(F.w_gdn_out, 512, 1024, 32, (bf16*)(F.ws + WS_WTGD), scr, r, F.lane); continue; } r -= I_G;
        p0_transpose_item<false>(F.w_o, 1024, 1024, 32, (bf16*)(F.ws + WS_WTO), scr, r, F.lane);
    }
}
__device__ __forceinline__ void p1_rows(Frame& F) {
    const float* MOD = (const float*)(F.ws + WS_MOD); bf16* H = (bf16*)(F.ws + WS_H);
    for (int row = F.gw; row < NROWS; row += F.NGW) {
        const float* xr = row < NTOK ? F.x + (size_t)row * DM : F.ctx + (size_t)(row - NTOK) * DM; const int r = row < NTOK ? row / SEQ : BATCH;
        const f32x4* xv = (const f32x4*)xr + F.lane; f32x4 v[4]; float s = 0.f;
#pragma unroll
        for (int j = 0; j < 4; ++j) { v[j] = xv[64 * j]; s += (v[j].x * v[j].x + v[j].y * v[j].y) + (v[j].z * v[j].z + v[j].w * v[j].w); }
        const float rstd = 1.f / sqrtf(wave_sum(s) * (1.f / DM) + EPSV);
        const f32x4* sh = (const f32x4*)(MOD + (size_t)r * 3072) + F.lane; const f32x4* sc = sh + 256; const f32x4* g = (const f32x4*)F.norm_g + F.lane;
        unsigned long long* o8 = (unsigned long long*)(H + (size_t)row * DM) + F.lane;
#pragma unroll
        for (int j = 0; j < 4; ++j) { const f32x4 gg = g[64 * j], cc = sc[64 * j], hh = sh[64 * j]; const f32x4 y = (v[j] * rstd * gg) * (cc + 1.f) + hh;
            o8[64 * j] = (unsigned long long)pk2(y.x, y.y) | ((unsigned long long)pk2(y.z, y.w) << 32); }
    }
}
__device__ __forceinline__ void p3_conv(Frame& F) {
    const bf16* PRE = (const bf16*)(F.ws + WS_PRE); bf16* POST = (bf16*)(F.ws + WS_POST);
    for (int row = F.gw; row < NROWS; row += F.NGW) {
        const bool lat = row < NTOK; int base, t, len;
        if (lat) { base = (row / SEQ) * SEQ; t = row % SEQ; len = SEQ; } else { const int rr = row - NTOK; base = NTOK + (rr / CTXL) * CTXL; t = rr % CTXL; len = CTXL; }
        const int gx = t & 63;
#pragma unroll 1
        for (int wh = 0; wh < 3; ++wh) {
            float acc[8];
#pragma unroll
            for (int e = 0; e < 8; ++e) acc[e] = 0.f;
            const int ch = wh * 512 + 8 * F.lane;
#pragma unroll 1
            for (int dy = (lat ? 0 : 1); dy < (lat ? 3 : 2); ++dy)
#pragma unroll
                for (int dx = 0; dx < 3; ++dx) {
                    int tt; bool ok;
                    if (lat) { const int yy = (t >> 6) + dy - 1, xx = gx + dx - 1; ok = yy >= 0 && yy < SEQ / 64 && xx >= 0 && xx < 64; tt = yy * 64 + xx; }
                    else { tt = t + dx - 1; ok = tt >= 0 && tt < len; }
                    if (!ok) continue;
                    const v4u w = *(const v4u*)(PRE + (size_t)(base + tt) * 1536 + ch); float v[8]; unpack8(w, v);
                    const f32x4* cw = (const f32x4*)(F.gdn_conv + (size_t)(dy * 3 + dx) * 1536 + ch); const f32x4 c0 = cw[0], c1 = cw[1];
#pragma unroll
                    for (int e = 0; e < 4; ++e) { acc[e] += v[e] * c0[e]; acc[4 + e] += v[4 + e] * c1[e]; }
                }
            float ss = 0.f;
#pragma unroll
            for (int e = 0; e < 8; ++e) { acc[e] = fsilu(acc[e]); ss += acc[e] * acc[e]; }
            if (wh < 2) { ss = grp16_sum(ss); float scl = 1.f / sqrtf(ss + EPSV); if (wh == 0) scl *= 0.08838834764831845f;
#pragma unroll
                for (int e = 0; e < 8; ++e) acc[e] *= scl; }
            *(v4u*)(POST + (size_t)row * 1536 + ch) = pack8(acc);
        }
    }
}
__device__ __forceinline__ int scan_row(int b, int dir, int pos, bool& latent) {
    if (pos < CTXL) { latent = false; return NTOK + b * CTXL + (dir ? CTXL - 1 - pos : pos); }
    const int q = pos - CTXL; latent = true; return b * SEQ + (dir ? SEQ - 1 - q : q);
}
__device__ __forceinline__ void p4_scan_naive(Frame& F) {
    const int item = F.vcu; if (item < 128 || F.tid >= 128) return;
    const int e = F.tid, br = item < 192 ? 1 : 0, bid = item & 63, dir = bid & 1, h = (bid >> 1) & 3, b = bid >> 3;
    if (br == 0 ? !DBG_NAIVE_GDN : !DBG_NAIVE_GLA) return;
    const float* SM = (const float*)(F.ws + WS_SM);
    if (br == 0) {
        const bf16* POST = (const bf16*)(F.ws + WS_POST); bf16* O = (bf16*)(F.ws + (dir ? WS_OBB : WS_OBF));
        float S[128];
#pragma unroll
        for (int d = 0; d < 128; ++d) S[d] = 0.f;
        const float A = -expf(F.gdn_a_log[dir * 4 + h]), dtb = F.gdn_dt_bias[dir * 4 + h];
        for (int pos = 0; pos < CTXL + SEQ; ++pos) {
            bool lat; const int row = scan_row(b, dir, pos, lat);
            const v4u* q = (const v4u*)(POST + (size_t)row * 1536 + h * 128); const v4u* k = (const v4u*)(POST + (size_t)row * 1536 + 512 + h * 128);
            const float v = bf2f(POST[(size_t)row * 1536 + 1024 + h * 128 + e]);
            const float beta = 1.f / (1.f + expf(-SM[(size_t)row * NSM + 32 + dir * 4 + h]));
            const float eg = expf(A * softplusf_(SM[(size_t)row * NSM + 40 + dir * 4 + h] + dtb));
            float ks = 0.f;
#pragma unroll
            for (int c = 0; c < 16; ++c) { float kv[8]; unpack8(k[c], kv); if ((c & 3) == 3) asm volatile("" ::: "memory");
#pragma unroll
                for (int j = 0; j < 8; ++j) ks += kv[j] * S[c * 8 + j]; }
            const float vn = beta * (v - eg * ks); float o = 0.f;
#pragma unroll
            for (int c = 0; c < 16; ++c) { float kv[8], qv[8]; unpack8(k[c], kv); unpack8(q[c], qv); if ((c & 1) == 1) asm volatile("" ::: "memory");
#pragma unroll
                for (int j = 0; j < 8; ++j) { S[c * 8 + j] = eg * S[c * 8 + j] + kv[j] * vn; o += qv[j] * S[c * 8 + j]; } }
            if (lat) O[(size_t)row * 512 + h * 128 + e] = (bf16)f2bf(o);
        }
    } else {
        const bf16* AQ = (const bf16*)(F.ws + WS_AQ); const bf16* AK = (const bf16*)(F.ws + WS_AK); const bf16* AV = (const bf16*)((unsigned char*)F.out + DO_DBGAV); bf16* O = (bf16*)(F.ws + (dir ? WS_OAB : WS_OAF));
        float S[64];
#pragma unroll
        for (int d = 0; d < 64; ++d) S[d] = 0.f;
        for (int pos = 0; pos < CTXL + SEQ; ++pos) {
            bool lat; const int row = scan_row(b, dir, pos, lat);
            const float v = bf2f(AV[(size_t)row * 512 + h * 128 + e]);
            float lr[16];
#pragma unroll
            for (int r = 0; r < 16; ++r) lr[r] = SM[(size_t)row * NSM + dir * 16 + r];
            float o = 0.f; int zo = 0; asm volatile("" : "+v"(zo));
#pragma unroll
            for (int d = 0; d < 64; ++d) {
                float u = F.gla_ub[dir * 256 + h * 64 + d + zo];
#pragma unroll
                for (int r = 0; r < 16; ++r) u += lr[r] * F.gla_up[(size_t)(dir * 16 + r) * 256 + h * 64 + d + zo];
                const float dec = expf(logsigf_(u) * (1.f / 16.f));
                S[d] = dec * S[d] + bf2f(AK[(size_t)row * 256 + h * 64 + d]) * v;
                if (lat) o += bf2f(AQ[(size_t)row * 256 + h * 64 + d]) * S[d];
            }
            if (lat) O[(size_t)row * 512 + h * 128 + e] = (bf16)f2bf(o);
        }
    }
}
__device__ __forceinline__ void p5_y(Frame& F) {
    for (int row = F.gw; row < NTOK; row += F.NGW) {
#pragma unroll
        for (int br = 0; br < 2; ++br) {
            const bf16* OF = (const bf16*)(F.ws + (br ? WS_OBF : WS_OAF)); const bf16* OB = (const bf16*)(F.ws + (br ? WS_OBB : WS_OAB));
            const bf16* G = (const bf16*)(F.ws + (br ? WS_BG : WS_AG)); bf16* Y = (bf16*)(F.ws + (br ? WS_YB : WS_YA)); const float* on = br ? F.gdn_onorm : F.gla_onorm;
            const size_t off = (size_t)row * 512 + 8 * F.lane; float a[8], bb[8], g[8];
            unpack8(*(const v4u*)(OF + off), a); unpack8(*(const v4u*)(OB + off), bb); unpack8(*(const v4u*)(G + off), g);
            float ss = 0.f;
#pragma unroll
            for (int e = 0; e < 8; ++e) { a[e] += bb[e]; ss += a[e] * a[e]; }
            ss = grp16_sum(ss); const float rs = 1.f / sqrtf(ss * (1.f / 128.f) + EPSV);
            const f32x4* onv = (const f32x4*)(on + ((8 * F.lane) & 127)); const f32x4 o0 = onv[0], o1 = onv[1];
#pragma unroll
            for (int e = 0; e < 4; ++e) { a[e] = a[e] * rs * o0[e] * g[e]; a[4 + e] = a[4 + e] * rs * o1[e] * g[4 + e]; }
            *(v4u*)(Y + off) = pack8(a);
        }
    }
}
__device__ __forceinline__ void p8_final(Frame& F) {
    const float* ROWSS = (const float*)(F.ws + WS_ROWSS);
    for (int row = F.gw; row < NTOK; row += F.NGW) {
        const float rs = 1.f / sqrtf(ROWSS[row] * (1.f / DM) + EPSV);
        f32x4* y = (f32x4*)(F.out + (size_t)row * DM) + F.lane; const f32x4* g = (const f32x4*)F.final_g + F.lane;
#pragma unroll
        for (int j = 0; j < 4; ++j) y[64 * j] = y[64 * j] * rs * g[64 * j];
    }
}

typedef short bf16x8_t __attribute__((ext_vector_type(8)));
typedef float f4 __attribute__((ext_vector_type(4)));
#define MFMA16(a, b, c) __builtin_amdgcn_mfma_f32_16x16x32_bf16((a), (b), (c), 0, 0, 0)
constexpr int NCH = 36;
constexpr int NITEM = BATCH * 4 * NCH;
__device__ __forceinline__ int chunk_row0(int b, int cid) { return cid < 4 ? NTOK + b * CTXL + cid * 64 : b * SEQ + (cid - 4) * 64; }
__device__ __forceinline__ int step_cid(int dir, int s) { return dir ? (s < 4 ? 3 - s : 35 - (s - 4)) : s; }
typedef __bf16 bf16x2_t __attribute__((ext_vector_type(2)));
typedef float f2_t __attribute__((ext_vector_type(2)));
__device__ __forceinline__ unsigned cvtpk(float lo, float hi) { const f2_t v = {lo, hi}; return __builtin_bit_cast(unsigned, __builtin_convertvector(v, bf16x2_t)); }
__device__ __forceinline__ int img_off_perm(int row, int k, int nks) { const int o = k & 31; return (((row >> 4) * nks + (k >> 5)) * 64 + (((o & 15) >> 2) << 4) + (row & 15)) * 8 + (o & 3) + ((o >> 4) << 2); }
__device__ __forceinline__ int img_off_nat(int row, int k, int nks) { const int o = k & 31; return (((row >> 4) * nks + (k >> 5)) * 64 + ((o >> 3) << 4) + (row & 15)) * 8 + (o & 7); }

__device__ __forceinline__ v4u lds_frag_perm(const LAS bf16* t, int LD, int row0, int k0, int lane) {
    const LAS bf16* p = t + (row0 + (lane & 15)) * LD + k0 + 4 * (lane >> 4); const v2u a = *(const LAS v2u*)p, b = *(const LAS v2u*)(p + 16); return (v4u){a.x, a.y, b.x, b.y};
}
__device__ __forceinline__ v4u lds_frag_nat(const LAS bf16* t, int LD, int row0, int k0, int lane) {
    return *(const LAS v4u*)(t + (row0 + (lane & 15)) * LD + k0 + 8 * (lane >> 4));
}
__device__ __forceinline__ void p3a_conv_job(Frame& F, int item, int wh, int strip) {
    int lane_ = F.lane; asm volatile("" : "+v"(lane_));
    const int lane = lane_, l16 = lane & 15, tq = lane >> 4;
    const int cid = item % NCH, h = (item / NCH) & 3, b = item / (NCH * 4); const bool lat = cid >= 4;
    const bf16* PRE = (const bf16*)(F.ws + WS_PRE) + wh * 512 + h * 128 + 8 * l16;
    const float* cwb = F.gdn_conv + wh * 512 + h * 128 + 8 * l16;
    const int p0 = 16 * strip + 4 * tq;
    float acc[4][8];
#pragma unroll
    for (int t = 0; t < 4; ++t)
#pragma unroll
        for (int e = 0; e < 8; ++e) acc[t][e] = 0.f;
#pragma unroll
    for (int dy = 0; dy < 3; ++dy) {
        if (!lat && dy != 1) continue;
        float v[6][8];
#pragma unroll
        for (int j = 0; j < 6; ++j) { bool ok; int nrow;
            if (lat) { const int yy = cid - 4 + dy - 1, xx = p0 + j - 1; ok = yy >= 0 && yy < 32 && xx >= 0 && xx < 64; nrow = b * SEQ + yy * 64 + xx; }
            else { const int tt = cid * 64 + p0 + j - 1; ok = tt >= 0 && tt < CTXL; nrow = NTOK + b * CTXL + tt; }
            v4u w = *(const v4u*)(PRE + (size_t)(ok ? nrow : (lat ? b * SEQ : NTOK + b * CTXL)) * 1536);
            if (!ok) w = (v4u){0u, 0u, 0u, 0u}; unpack8(w, v[j]); }
#pragma unroll
        for (int dx = 0; dx < 3; ++dx) { const f32x4* cw = (const f32x4*)(cwb + (size_t)(dy * 3 + dx) * 1536); const f32x4 c0 = cw[0], c1 = cw[1];
#pragma unroll
            for (int t = 0; t < 4; ++t)
#pragma unroll
                for (int e = 0; e < 4; ++e) { acc[t][e] += v[t + dx][e] * c0[e]; acc[t][4 + e] += v[t + dx][4 + e] * c1[e]; } }
    }
#pragma unroll
    for (int t = 0; t < 4; ++t) { float ss = 0.f;
#pragma unroll
        for (int e = 0; e < 8; ++e) { acc[t][e] = fsilu(acc[t][e]); ss += acc[t][e] * acc[t][e]; }
        if (wh < 2) { ss = grp16_sum(ss); float scl = 1.f / sqrtf(ss + EPSV); if (wh == 0) scl *= 0.08838834764831845f;
#pragma unroll
            for (int e = 0; e < 8; ++e) acc[t][e] *= scl; } }
    const int li = lat ? ((b * 4 + h) * 32 + cid - 4) : 0;
    if (wh < 2) {
        bf16* IMG = wh == 0 ? (bf16*)((unsigned char*)F.out + DO_QIMG) + (size_t)li * 8192 : (bf16*)(F.ws + WS_KIMG) + (size_t)item * 8192;
#pragma unroll
        for (int t = 0; t < 4; ++t) { *(v2u*)(IMG + img_off_perm(p0 + t, 8 * l16, 4)) = (v2u){pk2(acc[t][0], acc[t][1]), pk2(acc[t][2], acc[t][3])};
            *(v2u*)(IMG + img_off_perm(p0 + t, 8 * l16 + 4, 4)) = (v2u){pk2(acc[t][4], acc[t][5]), pk2(acc[t][6], acc[t][7])}; }
    }
    if (wh == 1) {
        bf16* KTIMG = (bf16*)(F.ws + WS_KTIMG) + (size_t)item * 8192;
#pragma unroll
        for (int e = 0; e < 8; ++e) *(v2u*)(KTIMG + (((l16 >> 1) * 2 + (strip >> 1)) * 64 + tq * 16 + 8 * (l16 & 1) + e) * 8 + 4 * (strip & 1)) = (v2u){pk2(acc[0][e], acc[1][e]), pk2(acc[2][e], acc[3][e])};
    }
    if (wh == 2) {
        bf16* VT = (bf16*)(F.ws + WS_VT) + (size_t)item * 8192;
#pragma unroll
        for (int e = 0; e < 8; ++e) *(v2u*)(VT + (8 * l16 + e) * 64 + p0) = (v2u){pk2(acc[0][e], acc[1][e]), pk2(acc[2][e], acc[3][e])};
    }
}
__device__ __forceinline__ float wave_prefix(float v, int lane) {
#pragma unroll
    for (int o = 1; o < 64; o <<= 1) { const float t = __shfl_up(v, o); if (lane >= o) v += t; }
    return v;
}
__device__ __forceinline__ void p3b_gdn(Frame& F, int item, int dir, LAS unsigned char* scr) {
    int lane_ = F.lane; asm volatile("" : "+v"(lane_));
    const int lane = lane_, cid = item % NCH, h = (item / NCH) & 3, b = item / (NCH * 4); const bool lat = cid >= 4;
    const int row0 = chunk_row0(b, cid);
    const float* SM = (const float*)(F.ws + WS_SM);
    const float beta = 1.f / (1.f + __expf(-SM[(size_t)(row0 + lane) * NSM + 32 + dir * 4 + h]));
    const float g = -expf(F.gdn_a_log[dir * 4 + h]) * softplusf_(SM[(size_t)(row0 + lane) * NSM + 40 + dir * 4 + h] + F.gdn_dt_bias[dir * 4 + h]);
    float gam; { const float gs = dir ? __shfl(g, 63 - lane) : g; const float pf = wave_prefix(gs, lane); gam = dir ? __shfl(pf, 63 - lane) : pf; }
    const float gl = __shfl(gam, dir ? 0 : 63);
    float* SC = (float*)(F.ws + WS_SCAL) + (size_t)(item * 2 + dir) * 256;
    SC[lane] = __expf(gam); SC[64 + lane] = __expf(gl - gam); SC[128 + lane] = beta; if (lane == 0) SC[192] = __expf(gl);
    const bf16* KIMG = (const bf16*)(F.ws + WS_KIMG) + (size_t)item * 8192;
    bf16x8_t kf[16];
#pragma unroll
    for (int f = 0; f < 16; ++f) kf[f] = *(const bf16x8_t*)(KIMG + (f * 64 + lane) * 8);
    LAS float* As = (LAS float*)scr;
    const int c = lane & 15, q = lane >> 4;
#pragma unroll
    for (int rt = 0; rt < 4; ++rt)
#pragma unroll
        for (int ct = 0; ct < 4; ++ct) {
            f4 acc = {0.f, 0.f, 0.f, 0.f};
            const bool need = dir ? (ct >= rt) : (ct <= rt);
            if (need) {
#pragma unroll
                for (int ks = 0; ks < 4; ++ks) acc = MFMA16(kf[rt * 4 + ks], kf[ct * 4 + ks], acc); }
            const int pc = 16 * ct + c;
#pragma unroll
            for (int i = 0; i < 4; ++i) { const int pr = 16 * rt + 4 * q + i; const bool keep = need && (dir ? (pc > pr) : (pc < pr));
                const float sb_ = __shfl(beta, pr), sg_ = __shfl(gam, pr) - __shfl(gam, pc);
                As[pr * 64 + pc] = keep ? sb_ * acc[i] * __expf(sg_) : 0.f; }
        }
    LDS_WAIT();
    const int blk = lane >> 4, cs = lane & 15; float T[16];
#pragma unroll
    for (int is = 0; is < 16; ++is) { const LAS float* arow = As + (16 * blk + (dir ? 15 - is : is)) * 64 + 16 * blk; float a0 = (is == cs) ? 1.f : 0.f;
#pragma unroll
        for (int js = 0; js < is; ++js) a0 -= arow[dir ? 15 - js : js] * T[js];
        T[is] = a0; }
    asm volatile("" ::: "memory");
    LAS bf16* Dt = (LAS bf16*)(scr + 16384);
    { const int tcol = dir ? 15 - cs : cs;
#pragma unroll
        for (int is = 0; is < 16; ++is) Dt[(16 * blk + (dir ? 15 - is : is)) * 16 + tcol] = (bf16)f2bf(T[is]); }
    LDS_WAIT();
    bf16* TBIMG = (bf16*)(F.ws + WS_TBIMG) + (size_t)(item * 2 + dir) * 4096;
#pragma unroll
    for (int bb = 0; bb < 4; ++bb) { const v2u d = *(const LAS v2u*)(Dt + (16 * bb + c) * 16 + 4 * q); *(v4u*)(TBIMG + (bb * 64 + lane) * 8) = (v4u){d.x, d.y, 0u, 0u}; }
#pragma unroll
    for (int n = 0; n < 4; ++n) { const int rt = dir ? (2 - n > 0 ? 2 - n : 0) : (n + 1 < 3 ? n + 1 : 3), ks = dir ? (n != 3) : (n == 3);
        const LAS float* ap = As + (16 * rt + c) * 64 + 32 * ks + 4 * q; f4 p0 = *(const LAS f4*)ap, p1 = *(const LAS f4*)(ap + 16);
        if (ks == (rt >> 1)) { if (rt & 1) p1 = (f4){0.f, 0.f, 0.f, 0.f}; else p0 = (f4){0.f, 0.f, 0.f, 0.f}; }
        *(v4u*)(TBIMG + ((4 + n) * 64 + lane) * 8) = (v4u){cvtpk(-p0[0], -p0[1]), cvtpk(-p0[2], -p0[3]), cvtpk(-p1[0], -p1[1]), cvtpk(-p1[2], -p1[3])}; }
    if (!lat) { LDS_WAIT(); return; }
    LDS_WAIT();
    const bf16* QIMG = (const bf16*)((unsigned char*)F.out + DO_QIMG) + (size_t)((b * 4 + h) * 32 + cid - 4) * 8192;
    LAS bf16* Aq = (LAS bf16*)scr;
#pragma unroll
    for (int rt = 0; rt < 4; ++rt) {
        bf16x8_t qf[4];
#pragma unroll
        for (int ks = 0; ks < 4; ++ks) qf[ks] = *(const bf16x8_t*)(QIMG + ((rt * 4 + ks) * 64 + lane) * 8);
#pragma unroll
        for (int ct = 0; ct < 4; ++ct) {
            f4 acc = {0.f, 0.f, 0.f, 0.f};
            const bool need = dir ? (ct >= rt) : (ct <= rt);
            if (need) {
#pragma unroll
                for (int ks = 0; ks < 4; ++ks) acc = MFMA16(qf[ks], kf[ct * 4 + ks], acc); }
            const int pc = 16 * ct + c;
#pragma unroll
            for (int i = 0; i < 4; ++i) { const int pr = 16 * rt + 4 * q + i; const bool keep = need && (dir ? (pc >= pr) : (pc <= pr));
                const float sg_ = __shfl(gam, pr) - __shfl(gam, pc);
                Aq[pr * 72 + pc] = (bf16)f2bf(keep ? acc[i] * __expf(sg_) : 0.f); }
        }
    }
    LDS_WAIT();
    bf16* AQKIMG = (bf16*)((unsigned char*)F.out + DO_AQKIMG) + (size_t)(((b * 4 + h) * 32 + cid - 4) * 2 + dir) * 4096;
#pragma unroll
    for (int fr = 0; fr < 8; ++fr) *(v4u*)(AQKIMG + (fr * 64 + lane) * 8) = lds_frag_perm(Aq, 72, (fr >> 1) * 16, (fr & 1) * 32, lane);
    LDS_WAIT();
}
__device__ __forceinline__ void p3b_gla(Frame& F, int item, int dir, LAS unsigned char* scr) {
    int lane_ = F.lane; asm volatile("" : "+v"(lane_));
    const int lane = lane_, cid = item % NCH, h = (item / NCH) & 3, b = item / (NCH * 4); const bool lat = cid >= 4;
    const int row0 = chunk_row0(b, cid), c = lane & 15, q = lane >> 4;
    LAS bf16* Qe = (LAS bf16*)scr; LAS bf16* Ke = (LAS bf16*)(scr + 9216);
    {   const bf16* AKt = (const bf16*)(F.ws + WS_AK) + (size_t)row0 * 256 + h * 64; const bf16* AQt = (const bf16*)(F.ws + WS_AQ) + (size_t)row0 * 256 + h * 64;
#pragma unroll
        for (int j = 0; j < 8; ++j) { const int pc = lane + 64 * j, r = pc >> 3, ch = pc & 7;
            *(LAS v4u*)(Ke + r * 72 + ch * 8) = *(const v4u*)(AKt + r * 256 + ch * 8);
            if (lat) *(LAS v4u*)(Qe + r * 72 + ch * 8) = *(const v4u*)(AQt + r * 256 + ch * 8); }
    }
    f4 u[4][4];
    {   bf16x8_t Ahl[4], Ah0[4], B1[4], B2[4]; float ubv[4];
        const float* SMp = (const float*)(F.ws + WS_SM) + (size_t)row0 * NSM + dir * 16 + 8 * (q & 1);
#pragma unroll
        for (int rt = 0; rt < 4; ++rt) { const f4* ar = (const f4*)(SMp + (size_t)(16 * rt + c) * NSM); const f4 x0 = ar[0], x1 = ar[1]; float x[8] = {x0[0], x0[1], x0[2], x0[3], x1[0], x1[1], x1[2], x1[3]}, v[8];
#pragma unroll
            for (int j = 0; j < 8; ++j) { const float hi = __builtin_bit_cast(float, f2bf(x[j]) << 16); v[j] = q < 2 ? hi : x[j] - hi; }
            const v4u pk = pack8(v); Ahl[rt] = __builtin_bit_cast(bf16x8_t, pk); Ah0[rt] = __builtin_bit_cast(bf16x8_t, q < 2 ? pk : (v4u){0u, 0u, 0u, 0u}); }
#pragma unroll
        for (int ct = 0; ct < 4; ++ct) { float wh[8], wl[8];
#pragma unroll
            for (int j = 0; j < 8; ++j) { const float wv = F.gla_up[(size_t)(dir * 16 + 8 * (q & 1) + j) * 256 + h * 64 + 16 * ct + c]; wh[j] = __builtin_bit_cast(float, f2bf(wv) << 16); wl[j] = wv - wh[j]; }
            B1[ct] = __builtin_bit_cast(bf16x8_t, pack8(wh)); B2[ct] = __builtin_bit_cast(bf16x8_t, q < 2 ? pack8(wl) : (v4u){0u, 0u, 0u, 0u});
            ubv[ct] = F.gla_ub[dir * 256 + h * 64 + 16 * ct + c]; }
#pragma unroll
        for (int rt = 0; rt < 4; ++rt)
#pragma unroll
            for (int ct = 0; ct < 4; ++ct) { f4 acc = {ubv[ct], ubv[ct], ubv[ct], ubv[ct]}; acc = MFMA16(Ahl[rt], B1[ct], acc); acc = MFMA16(Ah0[rt], B2[ct], acc);
#pragma unroll
                for (int i = 0; i < 4; ++i) acc[i] = (fminf(acc[i], 0.f) - __logf(1.f + __expf(-fabsf(acc[i])))) * (1.f / 16.f);
                u[rt][ct] = acc; }
    }
    LDS_WAIT();
    bf16* KDTIMG = (bf16*)(F.ws + WS_KDTIMG) + (size_t)(item * 2 + dir) * 4096;
#pragma unroll
    for (int ct = 0; ct < 4; ++ct) {
        float pre[4][4], incl[4], T[4];
#pragma unroll
        for (int rt = 0; rt < 4; ++rt) { pre[rt][0] = u[rt][ct][0]; pre[rt][1] = pre[rt][0] + u[rt][ct][1]; pre[rt][2] = pre[rt][1] + u[rt][ct][2]; pre[rt][3] = pre[rt][2] + u[rt][ct][3];
            float x = pre[rt][3]; const float t1 = __shfl_up(x, 16); if (q >= 1) x += t1; const float t2 = __shfl_up(x, 32); if (q >= 2) x += t2; incl[rt] = x; }
#pragma unroll
        for (int rt = 0; rt < 4; ++rt) T[rt] = __shfl(incl[rt], c + 48);
        const float bl = (T[0] + T[1]) + (T[2] + T[3]); float off = 0.f;
        if (q == 0) ((float*)(F.ws + WS_EBL))[(size_t)(item * 2 + dir) * 64 + 16 * ct + c] = __expf(bl);
#pragma unroll
        for (int rt = 0; rt < 4; ++rt) { const float base = off + incl[rt] - pre[rt][3]; off += T[rt]; float kd[4];
#pragma unroll
            for (int i = 0; i < 4; ++i) { const float bf = base + pre[rt][i], bs = dir ? bl - bf + u[rt][ct][i] : bf; const float eb = __expf(bs);
                const int p = 16 * rt + 4 * q + i, d = 16 * ct + c; const float kk = bf2f(Ke[p * 72 + d]), qq = lat ? bf2f(Qe[p * 72 + d]) : 0.f;
                Qe[p * 72 + d] = (bf16)f2bf(qq * eb); Ke[p * 72 + d] = (bf16)f2bf(kk * __builtin_amdgcn_rcpf(eb)); kd[i] = kk * __expf(bl - bs); }
            *(v2u*)(KDTIMG + ((ct * 2 + (rt >> 1)) * 64 + ((2 * (rt & 1) + (q >> 1)) << 4) + c) * 8 + 4 * (q & 1)) = (v2u){pk2(kd[0], kd[1]), pk2(kd[2], kd[3])}; }
    }
    LDS_WAIT();
    if (!lat) return;
    bf16* QEIMG = (bf16*)((unsigned char*)F.out + DO_QEIMG) + (size_t)(((b * 4 + h) * 32 + cid - 4) * 2 + dir) * 4096;
#pragma unroll
    for (int fr = 0; fr < 8; ++fr) *(v4u*)(QEIMG + (fr * 64 + lane) * 8) = lds_frag_perm(Qe, 72, (fr >> 1) * 16, (fr & 1) * 32, lane);
    f4 att[4][4];
#pragma unroll
    for (int rt = 0; rt < 4; ++rt)
#pragma unroll
        for (int ct = 0; ct < 4; ++ct) { f4 acc = {0.f, 0.f, 0.f, 0.f};
            if (dir ? (ct >= rt) : (ct <= rt)) {
#pragma unroll
                for (int ks = 0; ks < 2; ++ks) { const v4u a = lds_frag_nat(Qe, 72, rt * 16, ks * 32, lane), bb = lds_frag_nat(Ke, 72, ct * 16, ks * 32, lane);
                    acc = MFMA16(__builtin_bit_cast(bf16x8_t, a), __builtin_bit_cast(bf16x8_t, bb), acc); } }
            att[rt][ct] = acc; }
    LDS_WAIT();
    LAS bf16* At = (LAS bf16*)scr;
#pragma unroll
    for (int rt = 0; rt < 4; ++rt)
#pragma unroll
        for (int ct = 0; ct < 4; ++ct) { const int pc = 16 * ct + c;
#pragma unroll
            for (int i = 0; i < 4; ++i) { const int pr = 16 * rt + 4 * q + i; const bool keep = dir ? (pc >= pr) : (pc <= pr);
                At[pr * 72 + pc] = (bf16)f2bf(keep ? att[rt][ct][i] : 0.f); } }
    LDS_WAIT();
    bf16* ATTIMG = (bf16*)((unsigned char*)F.out + DO_ATTIMG) + (size_t)(((b * 4 + h) * 32 + cid - 4) * 2 + dir) * 4096;
#pragma unroll
    for (int fr = 0; fr < 8; ++fr) *(v4u*)(ATTIMG + (fr * 64 + lane) * 8) = lds_frag_nat(At, 72, (fr >> 1) * 16, (fr & 1) * 32, lane);
    LDS_WAIT();
}
#ifndef PROBE_REP_A
#define PROBE_REP_A 1
#endif
#ifndef PROBE_REP_GDN
#define PROBE_REP_GDN 1
#endif
#ifndef PROBE_REP_GLA
#define PROBE_REP_GLA 1
#endif
__device__ __forceinline__ void p3_prep(Frame& F) {
    int nit = 0; for (int item = F.vcu; item < NITEM; item += F.G) ++nit;
#if !DBG_NAIVE_GDN
    if (F.tid == 0) F.MISC[17] = 0u;
    __syncthreads();
    for (int rep = 0; rep < PROBE_REP_A; ++rep)
    for (;;) {
        unsigned idx = 0u; if (F.lane == 0) idx = __hip_atomic_fetch_add((LAS unsigned*)(F.lds + MISC_OFF) + 17, 1u, __ATOMIC_RELAXED, __HIP_MEMORY_SCOPE_WORKGROUP);
        idx = (unsigned)__builtin_amdgcn_readfirstlane((int)idx) - (unsigned)(rep * (nit * 12 + NWAVES));
        if (idx >= (unsigned)(nit * 12)) break;
        const int item = F.vcu + (int)(idx / 12u) * F.G, wh = (int)(idx % 12u) >> 2, strip = (int)idx & 3;
        if (wh == 0 && (item % NCH) < 4) continue;
        p3a_conv_job(F, item, wh, strip);
    }
#endif
    if (F.tid == 0) F.MISC[16] = 0u;
    VM_WAIT(); __syncthreads();
    LAS unsigned char* scr = F.lds + F.wave * 18432;
    for (;;) {
        unsigned idx = 0u; if (F.lane == 0) idx = __hip_atomic_fetch_add((LAS unsigned*)(F.lds + MISC_OFF) + 16, 1u, __ATOMIC_RELAXED, __HIP_MEMORY_SCOPE_WORKGROUP);
        idx = (unsigned)__builtin_amdgcn_readfirstlane((int)idx);
        if (idx >= (unsigned)(nit * 4)) break;
        const int kind = idx >= (unsigned)(nit * 2), j = kind ? (int)idx - nit * 2 : (int)idx, item = F.vcu + (j >> 1) * F.G, dir = j & 1;
        if (kind == 0) {
#if !DBG_NAIVE_GDN
            for (int rep = 0; rep < PROBE_REP_GDN; ++rep) p3b_gdn(F, item, dir, scr);
#endif
        } else {
#if !DBG_NAIVE_GLA
            for (int rep = 0; rep < PROBE_REP_GLA; ++rep) p3b_gla(F, item, dir, scr);
#endif
        }
    }
}

__device__ __forceinline__ void glds1k(const bf16* g, LAS unsigned char* l, int lane) { __builtin_amdgcn_global_load_lds((const unsigned*)(g + lane * 8), (LAS unsigned*)l, 16, 0, 0); }
__device__ __forceinline__ void gdn_stage(Frame& F, int b, int h, int dir, int s) {
    const int cid = step_cid(dir, s), item = (b * 4 + h) * NCH + cid; const bool lat = cid >= 4; const size_t li = (size_t)(lat ? ((b * 4 + h) * 32 + cid - 4) : 0);
    LAS unsigned char* buf = F.lds + (s & 1) * 66560;
    if (F.wave < 4) return;
    if (F.wave == 4) glds1k((const bf16*)((const float*)(F.ws + WS_SCAL) + (size_t)(item * 2 + dir) * 256), buf + 65536, F.lane);
#pragma unroll
    for (int k = 0; k < 16; ++k) { const int fr = 16 * (F.wave - 4) + k; const bf16* src;
        if (fr < 16) src = (const bf16*)(F.ws + WS_KIMG) + (size_t)item * 8192 + fr * 512;
        else if (fr < 32) { if (!lat) continue; src = (const bf16*)((unsigned char*)F.out + DO_QIMG) + li * 8192 + (fr - 16) * 512; }
        else if (fr < 48) src = (const bf16*)(F.ws + WS_KTIMG) + (size_t)item * 8192 + (fr - 32) * 512;
        else if (fr < 56) src = (const bf16*)(F.ws + WS_TBIMG) + (size_t)(item * 2 + dir) * 4096 + (fr - 48) * 512;
        else { if (!lat) continue; src = (const bf16*)((unsigned char*)F.out + DO_AQKIMG) + (li * 2 + dir) * 4096 + (fr - 56) * 512; }
        glds1k(src, buf + fr * 1024, F.lane); }
}
__device__ __forceinline__ void gla_stage(Frame& F, int b, int h, int dir, int s) {
    if (F.wave < 4) return;
    const int cid = step_cid(dir, s), item = (b * 4 + h) * NCH + cid; const bool lat = cid >= 4; const size_t li = (size_t)(lat ? ((b * 4 + h) * 32 + cid - 4) : 0);
    LAS unsigned char* buf = F.lds + (s & 1) * 32768;
    if (F.wave == 4 && F.lane < 16) __builtin_amdgcn_global_load_lds((const unsigned*)((const float*)(F.ws + WS_EBL) + (size_t)(item * 2 + dir) * 64 + F.lane * 4), (LAS unsigned*)(buf + 24576), 16, 0, 0);
#pragma unroll
    for (int k = 0; k < 6; ++k) { const int fr = 6 * (F.wave - 4) + k; const bf16* src;
        if (fr < 8) { if (!lat) continue; src = (const bf16*)((unsigned char*)F.out + DO_QEIMG) + (li * 2 + dir) * 4096 + fr * 512; }
        else if (fr < 16) { if (!lat) continue; src = (const bf16*)((unsigned char*)F.out + DO_ATTIMG) + (li * 2 + dir) * 4096 + (fr - 8) * 512; }
        else src = (const bf16*)(F.ws + WS_KDTIMG) + (size_t)(item * 2 + dir) * 4096 + (fr - 16) * 512;
        glds1k(src, buf + fr * 1024, F.lane); }
}
struct GdnAux { v2u V[4]; };
__device__ __forceinline__ void gdn_aux_load(Frame& F, int b, int h, int dir, int s, int col, int q, GdnAux& a) {
    const int cid = step_cid(dir, s), item = (b * 4 + h) * NCH + cid;
    const bf16* VTp = (const bf16*)(F.ws + WS_VT) + (size_t)item * 8192 + col * 64;
#pragma unroll
    for (int rt = 0; rt < 4; ++rt) a.V[rt] = *(const v2u*)(VTp + 16 * rt + 4 * q);
}
__device__ __forceinline__ bf16x8_t pack_b(const f4& x, const f4& y) { const v4u t = {cvtpk(x[0], x[1]), cvtpk(x[2], x[3]), cvtpk(y[0], y[1]), cvtpk(y[2], y[3])}; return __builtin_bit_cast(bf16x8_t, t); }
template <int DIR>
__device__ __forceinline__ void p4_gdn(Frame& F, int idx) {
    int lane_ = F.lane; asm volatile("" : "+v"(lane_));
    const int half = idx & 1, dir = DIR, h = (idx >> 2) & 3, b = idx >> 4; const int lane = lane_, w = F.wave, c = lane & 15, q = lane >> 4;
    const int col = half * 64 + 16 * (w & 3) + c;
    bf16* O = (bf16*)(F.ws + (dir ? WS_OBB : WS_OBF));
    const f4 Z = {0.f, 0.f, 0.f, 0.f};
    f4 S[8];
#pragma unroll
    for (int u = 0; u < 8; ++u) S[u] = Z;
    GdnAux cur, nxt;
    gdn_stage(F, b, h, dir, 0); if (w < 4) gdn_aux_load(F, b, h, dir, 0, col, q, cur); else VM_WAIT(); __syncthreads();
#pragma unroll 1
    for (int s = 0; s < NCH; ++s) {
        if (s + 1 < NCH) { gdn_stage(F, b, h, dir, s + 1); if (w < 4) gdn_aux_load(F, b, h, dir, s + 1, col, q, nxt); }
        if (w < 4) {
            const int cid = step_cid(dir, s); const bool lat = cid >= 4;
            const LAS unsigned char* buf = F.lds + (s & 1) * 66560;
#ifdef EXP_SCAL_GLOBAL
            const float* SCL = (const float*)(F.ws + WS_SCAL) + (size_t)(((b * 4 + h) * NCH + cid) * 2 + dir) * 256;
#define SCLP const
#else
            const LAS float* SCL = (const LAS float*)(buf + 65536);
#define SCLP const LAS
#endif
#define FRAG(off, f) (*(const LAS bf16x8_t*)(buf + (off) + ((f) * 64 + lane) * 16))
            bf16x8_t Bs[4];
#pragma unroll
            for (int ks = 0; ks < 4; ++ks) Bs[ks] = pack_b(S[2 * ks], S[2 * ks + 1]);
            f4 KS[4], QS[4];
#pragma unroll
            for (int rt = 0; rt < 4; ++rt) { f4 a = Z, a2 = Z;
#pragma unroll
                for (int ks = 0; ks < 4; ++ks) { a = MFMA16(FRAG(0, rt * 4 + ks), Bs[ks], a); if (lat) a2 = MFMA16(FRAG(16384, rt * 4 + ks), Bs[ks], a2); }
                KS[rt] = a; QS[rt] = a2; }
            f4 tm[4], W[4];
#pragma unroll
            for (int rt = 0; rt < 4; ++rt) { const f4 Vr = {bflo(cur.V[rt].x), bfhi(cur.V[rt].x), bflo(cur.V[rt].y), bfhi(cur.V[rt].y)};
                tm[rt] = *(SCLP f4*)(SCL + 128 + 16 * rt + 4 * q) * (Vr - *(SCLP f4*)(SCL + 16 * rt + 4 * q) * KS[rt]); }
            if (DIR == 0) {
                W[0] = MFMA16(FRAG(49152, 0), pack_b(tm[0], Z), Z);
                W[1] = MFMA16(FRAG(49152, 1), pack_b(MFMA16(FRAG(49152, 4), pack_b(W[0], Z), tm[1]), Z), Z);
                const bf16x8_t b01 = pack_b(W[0], W[1]);
                W[2] = MFMA16(FRAG(49152, 2), pack_b(MFMA16(FRAG(49152, 5), b01, tm[2]), Z), Z);
                W[3] = MFMA16(FRAG(49152, 3), pack_b(MFMA16(FRAG(49152, 7), pack_b(W[2], Z), MFMA16(FRAG(49152, 6), b01, tm[3])), Z), Z);
            } else {
                W[3] = MFMA16(FRAG(49152, 3), pack_b(tm[3], Z), Z);
                W[2] = MFMA16(FRAG(49152, 2), pack_b(MFMA16(FRAG(49152, 4), pack_b(Z, W[3]), tm[2]), Z), Z);
                const bf16x8_t b23 = pack_b(W[2], W[3]);
                W[1] = MFMA16(FRAG(49152, 1), pack_b(MFMA16(FRAG(49152, 5), b23, tm[1]), Z), Z);
                W[0] = MFMA16(FRAG(49152, 0), pack_b(MFMA16(FRAG(49152, 7), pack_b(Z, W[1]), MFMA16(FRAG(49152, 6), b23, tm[0])), Z), Z);
            }
            bf16x8_t Bv[2], Bw[2];
#pragma unroll
            for (int ks = 0; ks < 2; ++ks) { Bv[ks] = pack_b(W[2 * ks], W[2 * ks + 1]); Bw[ks] = pack_b(W[2 * ks] * *(SCLP f4*)(SCL + 64 + 32 * ks + 4 * q), W[2 * ks + 1] * *(SCLP f4*)(SCL + 64 + 32 * ks + 16 + 4 * q)); }
            if (lat) {
                const int trow0 = chunk_row0(b, cid);
#pragma unroll
                for (int rt = 0; rt < 4; ++rt) { f4 a = *(SCLP f4*)(SCL + 16 * rt + 4 * q) * QS[rt];
#pragma unroll
                    for (int ks = 0; ks < 2; ++ks) a = MFMA16(FRAG(57344, rt * 2 + ks), Bv[ks], a);
#pragma unroll
                    for (int i = 0; i < 4; ++i) O[(size_t)(trow0 + 16 * rt + 4 * q + i) * 512 + h * 128 + col] = (bf16)f2bf(a[i]); }
            }
            const float egt = SCL[192];
#pragma unroll
            for (int u = 0; u < 8; ++u) { f4 a = S[u] * egt;
#pragma unroll
                for (int ks = 0; ks < 2; ++ks) a = MFMA16(FRAG(32768, u * 2 + ks), Bw[ks], a);
                S[u] = a; }
#undef FRAG
            cur = nxt;
        } else { VM_WAIT(); }
        LDS_WAIT(); __builtin_amdgcn_s_barrier(); asm volatile("" ::: "memory");
    }
}
__device__ __forceinline__ void p4_gla(Frame& F, int idx) {
    int lane_ = F.lane; asm volatile("" : "+v"(lane_));
    const int dir = idx & 1, h = (idx >> 1) & 3, b = idx >> 3; const int lane = lane_, w = F.wave, c = lane & 15, q = lane >> 4;
    const int col0 = 32 * (w & 3) + c;
    bf16* O = (bf16*)(F.ws + (dir ? WS_OAB : WS_OAF));
    const f4 Z = {0.f, 0.f, 0.f, 0.f};
    f4 S[2][4];
#pragma unroll
    for (int t = 0; t < 2; ++t)
#pragma unroll
        for (int u = 0; u < 4; ++u) S[t][u] = Z;
    bf16x8_t Vc[2][2], Vn[2][2];
    gla_stage(F, b, h, dir, 0);
    if (w < 4) { const bf16* VTp = (const bf16*)(F.ws + WS_VTA) + (size_t)((b * 4 + h) * NCH + step_cid(dir, 0)) * 8192 + col0 * 64;
#pragma unroll
        for (int t = 0; t < 2; ++t)
#pragma unroll
            for (int ks = 0; ks < 2; ++ks) Vc[t][ks] = *(const bf16x8_t*)(VTp + t * 1024 + 32 * ks + 8 * q); }
    else VM_WAIT();
    LDS_WAIT(); __builtin_amdgcn_s_barrier(); asm volatile("" ::: "memory");
#pragma unroll 1
    for (int s = 0; s < NCH; ++s) {
        if (s + 1 < NCH) { gla_stage(F, b, h, dir, s + 1);
            if (w < 4) { const bf16* VTp = (const bf16*)(F.ws + WS_VTA) + (size_t)((b * 4 + h) * NCH + step_cid(dir, s + 1)) * 8192 + col0 * 64;
#pragma unroll
                for (int t = 0; t < 2; ++t)
#pragma unroll
                    for (int ks = 0; ks < 2; ++ks) Vn[t][ks] = *(const bf16x8_t*)(VTp + t * 1024 + 32 * ks + 8 * q); } }
        if (w < 4) {
            const int cid = step_cid(dir, s); const bool lat = cid >= 4;
            const LAS unsigned char* buf = F.lds + (s & 1) * 32768;
#define FRAG(off, f) (*(const LAS bf16x8_t*)(buf + (off) + ((f) * 64 + lane) * 16))
            if (lat) {
                bf16x8_t Bs[2][2];
#pragma unroll
                for (int t = 0; t < 2; ++t)
#pragma unroll
                    for (int ks = 0; ks < 2; ++ks) Bs[t][ks] = pack_b(S[t][2 * ks], S[t][2 * ks + 1]);
                const int trow0 = chunk_row0(b, cid);
#pragma unroll
                for (int rt = 0; rt < 4; ++rt) { f4 a0 = Z, a1 = Z;
#pragma unroll
                    for (int ks = 0; ks < 2; ++ks) { const bf16x8_t fq = FRAG(0, rt * 2 + ks), fa = FRAG(8192, rt * 2 + ks);
                        a0 = MFMA16(fq, Bs[0][ks], a0); a1 = MFMA16(fq, Bs[1][ks], a1); a0 = MFMA16(fa, Vc[0][ks], a0); a1 = MFMA16(fa, Vc[1][ks], a1); }
#pragma unroll
                    for (int i = 0; i < 4; ++i) { bf16* op = O + (size_t)(trow0 + 16 * rt + 4 * q + i) * 512 + h * 128 + col0; op[0] = (bf16)f2bf(a0[i]); op[16] = (bf16)f2bf(a1[i]); } }
            }
#pragma unroll
            for (int u = 0; u < 4; ++u) { const f4 eb = *(const LAS f4*)(buf + 24576 + (16 * u + 4 * q) * 4); f4 a0 = S[0][u] * eb, a1 = S[1][u] * eb;
#pragma unroll
                for (int ks = 0; ks < 2; ++ks) { const bf16x8_t fk = FRAG(16384, u * 2 + ks); a0 = MFMA16(fk, Vc[0][ks], a0); a1 = MFMA16(fk, Vc[1][ks], a1); }
                S[0][u] = a0; S[1][u] = a1; }
#undef FRAG
#pragma unroll
            for (int t = 0; t < 2; ++t)
#pragma unroll
                for (int ks = 0; ks < 2; ++ks) Vc[t][ks] = Vn[t][ks];
        } else { VM_WAIT(); }
        LDS_WAIT(); __builtin_amdgcn_s_barrier(); asm volatile("" ::: "memory");
    }
}

__global__ void __launch_bounds__(NWAVES * 64, 2) mk_fwd(Args args) {
    extern __shared__ __attribute__((aligned(16))) unsigned char lds[];
    Frame F;
    F.lds = (LAS unsigned char*)lds; F.MISC = (volatile LAS unsigned*)(F.lds + MISC_OFF);
    F.tid = threadIdx.x; F.lane = F.tid & 63; F.wave = __builtin_amdgcn_readfirstlane(F.tid >> 6);
    F.G = gridDim.x; { const int bx = blockIdx.x; F.vcu = (F.G % 8 == 0) ? (bx % 8) * (F.G / 8) + bx / 8 : bx; }
    F.gw = F.vcu * NWAVES + F.wave; F.NGW = F.G * NWAVES;
    F.ws = args.ws; F.out = args.out; F.ctl = (unsigned*)(args.ws + WS_CTL);
    F.x = args.in[0]; F.c = args.in[1]; F.ctx = args.in[2]; F.c_ctx = args.in[3]; F.w_mod = args.in[4]; F.b_mod = args.in[5]; F.norm_g = args.in[6]; F.w_in = args.in[7];
    F.gla_up = args.in[8]; F.gla_ub = args.in[9]; F.gla_onorm = args.in[10]; F.gdn_conv = args.in[11]; F.gdn_a_log = args.in[12]; F.gdn_dt_bias = args.in[13]; F.gdn_onorm = args.in[14];
    F.w_gla_out = args.in[15]; F.w_gdn_out = args.in[16]; F.b_gate = args.in[17]; F.w_o = args.in[18]; F.final_g = args.in[19];
    for (int u = F.tid; u < (LDS_BYTES - MISC_OFF) / 4; u += NWAVES * 64) ((LAS unsigned*)(F.lds + MISC_OFF))[u] = 0u;
    __syncthreads();
    XcdBarrier bar = xcd_barrier_post(F.ctl + CW_BAR, F.MISC + 8);
#ifdef PROBE_BAR2
#define GRID_BAR() do { xcd_barrier(bar); xcd_barrier(bar); } while (0)
#else
#define GRID_BAR() xcd_barrier(bar)
#endif
    unsigned char* ws = args.ws;
    bf16* H = (bf16*)(ws + WS_H);
    p0_prologue(F); GRID_BAR();
#ifdef PROBE_DUP_P1
    p1_rows(F); GRID_BAR();
#endif
    p1_rows(F); GRID_BAR();
    {   pg8::Gemm g{H, (const bf16*)(ws + WS_WTIN), NROWS, 11 * 256, DM}; pg8::OrderA S; S.init(F.G, (int)blockIdx.x);
        pg8::EpiIn E{ws, (bf16*)args.out, (float*)(ws + WS_SM), F.b_gate, 0};
        pg8::gemm_phase<pg8::EpiIn, pg8::OrderA, PG8_ALIGN, PG8_SP2>(F.lds, g, S, E); }
    GRID_BAR();
#if DBG_NAIVE_GDN
    p3_conv(F);
#endif
    p3_prep(F); GRID_BAR();
#ifdef PROBE_DUP_P3
    p3_prep(F); GRID_BAR();
#endif
    if (F.vcu < 128) {
#if !DBG_NAIVE_GDN
        if ((F.vcu >> 1) & 1) p4_gdn<1>(F, F.vcu); else p4_gdn<0>(F, F.vcu);
#endif
    } else if (F.vcu < 192) {
#if !DBG_NAIVE_GLA
        p4_gla(F, F.vcu - 128);
#endif
    }
#if DBG_NAIVE_GDN || DBG_NAIVE_GLA
    p4_scan_naive(F);
#endif
    GRID_BAR();
#ifdef PROBE_DUP_P4
    if (F.vcu < 128) {
#if !DBG_NAIVE_GDN
        if ((F.vcu >> 1) & 1) p4_gdn<1>(F, F.vcu); else p4_gdn<0>(F, F.vcu);
#endif
    } else if (F.vcu < 192) {
#if !DBG_NAIVE_GLA
        p4_gla(F, F.vcu - 128);
#endif
    }
#if DBG_NAIVE_GDN || DBG_NAIVE_GLA
    p4_scan_naive(F);
#endif
    GRID_BAR();
#endif
    {   pg8::Gemm g{H, (const bf16*)(ws + WS_WTIN) + (size_t)2816 * DM, NTOK, 12 * 256, DM}; pg8::StaticOrder S; S.init(NTOK, 12 * 256, F.G, (int)blockIdx.x);
        pg8::EpiIn E{ws, (bf16*)args.out, (float*)(ws + WS_SM), F.b_gate, 11};
        pg8::gemm_phase<pg8::EpiIn, pg8::StaticOrder, PG8_ALIGN, PG8_SP2>(F.lds, g, S, E); }
    GRID_BAR();
#ifdef PROBE_DUP_P2B
    {   pg8::Gemm g{H, (const bf16*)(ws + WS_WTIN) + (size_t)2816 * DM, NTOK, 12 * 256, DM}; pg8::StaticOrder S; S.init(NTOK, 12 * 256, F.G, (int)blockIdx.x);
        pg8::EpiIn E{ws, (bf16*)args.out, (float*)(ws + WS_SM), F.b_gate, 11};
        pg8::gemm_phase<pg8::EpiIn, pg8::StaticOrder, PG8_ALIGN, PG8_SP2>(F.lds, g, S, E); }
    GRID_BAR();
#endif
    p5_y(F); GRID_BAR();
#ifdef PROBE_DUP_P5
    p5_y(F); GRID_BAR();
#endif
    {   pg8::Gemm g{(const bf16*)(ws + WS_YA), (const bf16*)(ws + WS_WTGA), NTOK, DM, 512}; pg8::StaticOrder S; S.init(NTOK, DM, F.G, (int)blockIdx.x);
        pg8::EpiGa E{(const bf16*)args.out, (float*)(ws + WS_TMP)};
        pg8::gemm_phase<pg8::EpiGa, pg8::StaticOrder, PG8_ALIGN, PG8_SP2>(F.lds, g, S, E); }
    GRID_BAR();
    {   pg8::Gemm g{(const bf16*)(ws + WS_YB), (const bf16*)(ws + WS_WTGD), NTOK, DM, 512}; pg8::StaticOrder S; S.init(NTOK, DM, F.G, (int)blockIdx.x);
        pg8::EpiGb E{(const bf16*)args.out, (const float*)(ws + WS_TMP), (bf16*)(ws + WS_MERGED)};
        pg8::gemm_phase<pg8::EpiGb, pg8::StaticOrder, PG8_ALIGN, PG8_SP2>(F.lds, g, S, E); }
    GRID_BAR();
    {   pg8::Gemm g{(const bf16*)(ws + WS_MERGED), (const bf16*)(ws + WS_WTO), NTOK, DM, DM}; pg8::StaticOrder S; S.init(NTOK, DM, F.G, (int)blockIdx.x);
        pg8::EpiOut E{F.x, (const float*)(ws + WS_MOD), args.out, (float*)(ws + WS_ROWSS)};
        pg8::gemm_phase<pg8::EpiOut, pg8::StaticOrder, PG8_ALIGN, PG8_SP2>(F.lds, g, S, E); }
    GRID_BAR();
    p8_final(F);
}

extern "C" void kernel_launch(void* const* d_in, const int* in_sizes, int n_in, void* d_out, int out_size, void* d_ws, size_t ws_size, hipStream_t stream) {
    static int grid = 0;
    if (grid == 0) {
        if (n_in != 20 || out_size != NTOK * DM || ws_size < WS_END) { fprintf(stderr, "kernel_launch: unexpected shapes (n_in %d, out %d, ws %zu); nothing launched\n", n_in, out_size, ws_size); grid = -1; return; }
        int dev = 0, cus = 0;
        if (hipGetDevice(&dev) != hipSuccess || hipDeviceGetAttribute(&cus, hipDeviceAttributeMultiprocessorCount, dev) != hipSuccess) { grid = -1; return; }
        if (hipFuncSetAttribute((const void*)mk_fwd, hipFuncAttributeMaxDynamicSharedMemorySize, LDS_BYTES) != hipSuccess) { fprintf(stderr, "kernel_launch: hipFuncSetAttribute failed\n"); grid = -1; return; }
        (void)hipGetLastError();
        grid = cus;
    }
    if (grid < 0) return;
    if (hipMemsetAsync((char*)d_ws + WS_CTL, 0, CTL_ZERO_BYTES, stream) != hipSuccess) { fprintf(stderr, "kernel_launch: memset failed\n"); return; }
    Args a{};
    for (int i = 0; i < 20; ++i) a.in[i] = (const float*)d_in[i];
    a.out = (float*)d_out; a.ws = (unsigned char*)d_ws;
    hipLaunchKernelGGL(mk_fwd, dim3(grid), dim3(NWAVES * 64), LDS_BYTES, stream, a);
}
```
